# Optimizing an MI355X kernel written in HIP

```python
import math
import jax
import jax.numpy as jnp
from jax import lax
import numpy as np


D_MODEL = 2048
BATCH = 16
SEQ = 2048
DEPTH = 2

CTX_LEN = 256
GRID_W = 64
EPS = 1e-6
N_BRANCH = 3
BRANCH_W = D_MODEL // 2

ATT_HD = 128
ATT_HEADS = BRANCH_W // ATT_HD
ATT_KV_HEADS = ATT_HEADS // 4
ATT_REP = ATT_HEADS // ATT_KV_HEADS
ATT_W = ATT_HEADS * ATT_HD
ATT_KV_W = ATT_KV_HEADS * ATT_HD
ATT_WIN = 128
ATT_BLOCK = 128
ATT_NSIDE = -(-ATT_WIN // ATT_BLOCK)
ATT_PAD = ATT_NSIDE * ATT_BLOCK
ATT_WIN_K = ATT_BLOCK + 2 * ATT_PAD
ATT_SCALE = ATT_HD ** -0.5
ROPE_BASE = 10000.0

ML_HEADS = 4
ML_HD = BRANCH_W // ML_HEADS
ML_W = ML_HEADS * ML_HD
ML_CHUNK = 64
ML_F_BIAS_LO = 3.0
ML_F_BIAS_HI = 6.0

SSM_HD = 64
SSM_HEADS = BRANCH_W // SSM_HD
SSM_GROUPS = 2
SSM_HPG = SSM_HEADS // SSM_GROUPS
SSM_STATE = 128
SSM_W = SSM_HEADS * SSM_HD
SSM_BC_W = SSM_GROUPS * SSM_STATE
SSM_CONV_CH = SSM_W + 2 * SSM_BC_W
SSM_CONV = 5
SSM_CHUNK = 64

IN_COLS = (('att_q', ATT_W), ('att_k', ATT_KV_W), ('att_v', ATT_KV_W), ('att_z', ATT_W),
           ('ml_q', ML_W), ('ml_k', ML_W), ('ml_v', ML_W), ('ml_o', ML_W), ('ml_z', ML_W),
           ('ml_gates', 4 * ML_HEADS),
           ('ssm_xbc', SSM_CONV_CH), ('ssm_dt', 2 * SSM_HEADS), ('ssm_z', SSM_W))
N_IN = 2 * ATT_W + 2 * ATT_KV_W + 5 * ML_W + 4 * ML_HEADS + SSM_CONV_CH + 2 * SSM_HEADS + SSM_W

kernel_name = 'hybrid_gated_swa_mlstm_ssd_dit'


def _rmsnorm(t, g):
    tf = t.astype(jnp.float32)
    tf = tf * lax.rsqrt(jnp.mean(tf * tf, -1, keepdims=True) + EPS)
    return (tf * g.astype(jnp.float32)).astype(t.dtype)


def _headnorm(t):
    return t * lax.rsqrt(jnp.mean(t * t, -1, keepdims=True) + EPS)


def _split_cols(u):
    out = {}
    off = 0
    for name, w in IN_COLS:
        out[name] = u[..., off:off + w]
        off += w
    return out


def _rev(t):
    return jnp.flip(t, axis=1)


def _chunks(t, ch):
    b, l = t.shape[:2]
    return jnp.moveaxis(t.reshape(b, l // ch, ch, *t.shape[2:]), 1, 0)


def _unchunks(t):
    t = jnp.moveaxis(t, 0, 1)
    return t.reshape(t.shape[0], t.shape[1] * t.shape[2], *t.shape[3:])


def _dwconv_centred(t, w, b):
    pad = w.shape[0] // 2
    y = lax.conv_general_dilated(t, w.astype(t.dtype)[:, None, :], window_strides=(1,),
                                 padding=[(pad, pad)], dimension_numbers=('NWC', 'WIO', 'NWC'),
                                 feature_group_count=t.shape[-1])
    return y + b.astype(t.dtype)


def _axial_rope_tables(row, col):
    n_freq = ATT_HD // 4
    inv = ROPE_BASE ** (-jnp.arange(n_freq, dtype=jnp.float32) / n_freq)
    ang = jnp.concatenate([row.astype(jnp.float32)[:, None] * inv,
                           col.astype(jnp.float32)[:, None] * inv], -1)
    return jnp.cos(ang), jnp.sin(ang)


def _rope(t, cos, sin):
    tf = t.astype(jnp.float32).reshape(*t.shape[:-1], ATT_HD // 2, 2)
    t0, t1 = tf[..., 0], tf[..., 1]
    cs = cos[None, :, None, :]
    sn = sin[None, :, None, :]
    out = jnp.stack([t0 * cs - t1 * sn, t0 * sn + t1 * cs], -1)
    return out.reshape(t.shape).astype(t.dtype)


def _sink_softmax(s, sink):
    m = jnp.maximum(jnp.max(s, -1, keepdims=True), sink)
    e = jnp.exp(s - m)
    return e / (jnp.sum(e, -1, keepdims=True) + jnp.exp(sink - m))


def _window_attention(q, k, v, kc, vc, sink_g):
    b_, s_ = q.shape[:2]
    nb = s_ // ATT_BLOCK
    qg = q.reshape(b_, s_, ATT_KV_HEADS, ATT_REP, ATT_HD)
    pad = ((0, 0), (ATT_PAD, ATT_PAD), (0, 0), (0, 0))
    kp = jnp.pad(k, pad)
    vp = jnp.pad(v, pad)
    sink_b = sink_g[None, :, :, None, None]

    def block(i):
        start = i * ATT_BLOCK
        qb = lax.dynamic_slice_in_dim(qg, start, ATT_BLOCK, axis=1)
        kb = lax.dynamic_slice_in_dim(kp, start, ATT_WIN_K, axis=1)
        vb = lax.dynamic_slice_in_dim(vp, start, ATT_WIN_K, axis=1)
        pos_q = start + jnp.arange(ATT_BLOCK)
        pos_k = start - ATT_PAD + jnp.arange(ATT_WIN_K)
        valid = ((jnp.abs(pos_q[:, None] - pos_k[None, :]) <= ATT_WIN)
                 & (pos_k >= 0)[None, :] & (pos_k < s_)[None, :])
        s_loc = jnp.einsum('bqgrd,bkgd->bgrqk', qb, kb).astype(jnp.float32) * ATT_SCALE
        s_loc = jnp.where(valid, s_loc, -jnp.inf)
        s_ctx = jnp.einsum('bqgrd,bkgd->bgrqk', qb, kc).astype(jnp.float32) * ATT_SCALE
        p = _sink_softmax(jnp.concatenate([s_loc, s_ctx], -1), sink_b).astype(v.dtype)
        return (jnp.einsum('bgrqk,bkgd->bqgrd', p[..., :ATT_WIN_K], vb)
                + jnp.einsum('bgrqk,bkgd->bqgrd', p[..., ATT_WIN_K:], vc))

    o = lax.map(block, jnp.arange(nb))
    return jnp.moveaxis(o, 0, 1).reshape(b_, s_, ATT_W)


def _ctx_attention(qc, kc, vc, sink_g):
    b_, l_ = qc.shape[:2]
    qg = qc.reshape(b_, l_, ATT_KV_HEADS, ATT_REP, ATT_HD)
    s = jnp.einsum('bqgrd,bkgd->bgrqk', qg, kc).astype(jnp.float32) * ATT_SCALE
    p = _sink_softmax(s, sink_g[None, :, :, None, None]).astype(vc.dtype)
    return jnp.einsum('bgrqk,bkgd->bqgrd', p, vc).reshape(b_, l_, ATT_W)


def _attention_branch(u, uc, sink, cos, sin, need_ctx):
    b_, s_ = u['att_q'].shape[:2]
    lc = uc['att_q'].shape[1]
    q = _rope(u['att_q'].reshape(b_, s_, ATT_HEADS, ATT_HD), cos, sin)
    k = _rope(u['att_k'].reshape(b_, s_, ATT_KV_HEADS, ATT_HD), cos, sin)
    v = u['att_v'].reshape(b_, s_, ATT_KV_HEADS, ATT_HD)
    kc = uc['att_k'].reshape(b_, lc, ATT_KV_HEADS, ATT_HD)
    vc = uc['att_v'].reshape(b_, lc, ATT_KV_HEADS, ATT_HD)
    sink_g = sink.astype(jnp.float32).reshape(ATT_KV_HEADS, ATT_REP)
    o = _window_attention(q, k, v, kc, vc, sink_g) * jax.nn.silu(u['att_z'])
    oc = None
    if need_ctx:
        qc = uc['att_q'].reshape(b_, lc, ATT_HEADS, ATT_HD)
        oc = _ctx_attention(qc, kc, vc, sink_g) * jax.nn.silu(uc['att_z'])
    return o, oc


def _mlstm_scan(q, k, v, ig, lf, state):
    tri = jnp.tril(jnp.ones((ML_CHUNK, ML_CHUNK), bool))

    def step(carry, inp):
        c_prev, n_prev, m_prev = carry
        qc, kc, vc, ic, fc = inp
        bcum = jnp.cumsum(fc, axis=1)
        inter = bcum + m_prev[:, None, :]
        dmat = bcum[:, :, None, :] - bcum[:, None, :, :] + ic[:, None, :, :]
        dmat = jnp.where(tri[None, :, :, None], dmat, -jnp.inf)
        mt = jnp.maximum(inter, jnp.max(dmat, axis=2))
        w = jnp.exp(dmat - mt[:, :, None, :])
        qk = jnp.einsum('bthd,bshd->btsh', qc, kc).astype(jnp.float32) * w
        e_int = jnp.exp(inter - mt)
        num = (e_int[..., None] * jnp.einsum('bthd,bhde->bthe', qc, c_prev)
               + jnp.einsum('btsh,bshe->bthe', qk, vc))
        den = e_int * jnp.einsum('bthd,bhd->bth', qc, n_prev) + jnp.sum(qk, axis=2)
        h = num / jnp.maximum(jnp.abs(den), jnp.exp(-mt))[..., None]
        m_new = mt[:, -1]
        wdec = jnp.exp(bcum[:, -1:] - bcum + ic - m_new[:, None, :])
        sp = jnp.exp(bcum[:, -1] + m_prev - m_new)
        c_new = sp[..., None, None] * c_prev + jnp.einsum('bsh,bshd,bshe->bhde', wdec, kc, vc)
        n_new = sp[..., None] * n_prev + jnp.einsum('bsh,bshd->bhd', wdec, kc)
        return (c_new, n_new, m_new), h

    xs = tuple(_chunks(t, ML_CHUNK) for t in (q, k, v, ig, lf))
    final, hs = lax.scan(step, state, xs)
    return final, _unchunks(hs)


def _mlstm_branch(u, uc, gate_bias, norm_g, need_ctx):
    gb = gate_bias.astype(jnp.float32)

    def prep(cols):
        b_, l_ = cols['ml_q'].shape[:2]
        hd = lambda t: t.reshape(b_, l_, ML_HEADS, ML_HD)
        q = hd(cols['ml_q'])
        k = hd(cols['ml_k']) * (ML_HD ** -0.5)
        v = hd(cols['ml_v'])
        g = cols['ml_gates'].astype(jnp.float32).reshape(b_, l_, 4, ML_HEADS) + gb
        return (q, k, v, g[:, :, 0], jax.nn.log_sigmoid(g[:, :, 1]),
                g[:, :, 2], jax.nn.log_sigmoid(g[:, :, 3]))

    def finish(cols, h_sum):
        b_, l_ = cols['ml_o'].shape[:2]
        o = jax.nn.sigmoid(cols['ml_o'].astype(jnp.float32)).reshape(b_, l_, ML_HEADS, ML_HD)
        hn = _headnorm(o * h_sum).reshape(b_, l_, ML_W)
        out = hn * norm_g.astype(jnp.float32) * jax.nn.silu(cols['ml_z'].astype(jnp.float32))
        return out.astype(cols['ml_z'].dtype)

    qc, kc, vc, igf_c, lff_c, igb_c, lfb_c = prep(uc)
    b_ = qc.shape[0]
    st0 = (jnp.zeros((b_, ML_HEADS, ML_HD, ML_HD), jnp.float32),
           jnp.zeros((b_, ML_HEADS, ML_HD), jnp.float32),
           jnp.zeros((b_, ML_HEADS), jnp.float32))
    st_f, hc_f = _mlstm_scan(qc, kc, vc, igf_c, lff_c, st0)
    st_b, hc_b = _mlstm_scan(_rev(qc), _rev(kc), _rev(vc), _rev(igb_c), _rev(lfb_c), st0)
    q, k, v, igf, lff, igb, lfb = prep(u)
    _, h_f = _mlstm_scan(q, k, v, igf, lff, st_f)
    _, h_b = _mlstm_scan(_rev(q), _rev(k), _rev(v), _rev(igb), _rev(lfb), st_b)
    out = finish(u, h_f + _rev(h_b))
    out_c = finish(uc, hc_f + _rev(hc_b)) if need_ctx else None
    return out, out_c


def _ssd_scan(xs, dt, a, bm, cm, h0):
    tri = jnp.tril(jnp.ones((SSM_CHUNK, SSM_CHUNK), bool))

    def step(h, inp):
        xc, dtc, bc, cc = inp
        cum = jnp.cumsum(dtc * a, axis=1)
        seg = cum[:, :, None] - cum[:, None, :]
        lmat = jnp.exp(jnp.where(tri[None, :, :, None, None], seg, -jnp.inf))
        cb = jnp.einsum('btgn,bsgn->btsg', cc, bc).astype(jnp.float32)
        mix = cb[..., None] * lmat * dtc[:, None]
        y = (jnp.einsum('btsgr,bsgrp->btgrp', mix, xc)
             + jnp.exp(cum)[..., None] * jnp.einsum('btgn,bgrnp->btgrp', cc, h))
        wdec = jnp.exp(cum[:, -1:] - cum) * dtc
        h_new = (jnp.exp(cum[:, -1])[..., None, None] * h
                 + jnp.einsum('bsgr,bsgn,bsgrp->bgrnp', wdec, bc, xc))
        return h_new, y

    seqs = tuple(_chunks(t, SSM_CHUNK) for t in (xs, dt, bm, cm))
    final, ys = lax.scan(step, h0, seqs)
    return final, _unchunks(ys)


def _ssd_branch(u, uc, conv_w, conv_b, dt_bias, a_log, d_skip, norm_g, need_ctx):
    a = (-jnp.exp(a_log.astype(jnp.float32))).reshape(2, SSM_GROUPS, SSM_HPG)
    dsk = d_skip.astype(jnp.float32).reshape(SSM_GROUPS, SSM_HPG)

    def prep(cols):
        b_, l_ = cols['ssm_xbc'].shape[:2]
        xbc = jax.nn.silu(_dwconv_centred(cols['ssm_xbc'], conv_w, conv_b))
        xs = xbc[..., :SSM_W].reshape(b_, l_, SSM_GROUPS, SSM_HPG, SSM_HD)
        bm = xbc[..., SSM_W:SSM_W + SSM_BC_W].reshape(b_, l_, SSM_GROUPS, SSM_STATE)
        cm = xbc[..., SSM_W + SSM_BC_W:].reshape(b_, l_, SSM_GROUPS, SSM_STATE)
        dt = jax.nn.softplus(cols['ssm_dt'].astype(jnp.float32).reshape(b_, l_, 2, SSM_HEADS)
                             + dt_bias.astype(jnp.float32))
        dt = dt.reshape(b_, l_, 2, SSM_GROUPS, SSM_HPG)
        return xs, bm, cm, dt[:, :, 0], dt[:, :, 1]

    def finish(cols, xs, y_sum):
        b_, l_ = xs.shape[:2]
        y = (y_sum + dsk[..., None] * xs.astype(jnp.float32)).reshape(b_, l_, SSM_W)
        y = y * jax.nn.silu(cols['ssm_z'].astype(jnp.float32))
        return _rmsnorm(y, norm_g).astype(cols['ssm_z'].dtype)

    xc, bc, cc, dtf_c, dtb_c = prep(uc)
    h0 = jnp.zeros((xc.shape[0], SSM_GROUPS, SSM_HPG, SSM_STATE, SSM_HD), jnp.float32)
    hf, yc_f = _ssd_scan(xc, dtf_c, a[0], bc, cc, h0)
    hb, yc_b = _ssd_scan(_rev(xc), _rev(dtb_c), a[1], _rev(bc), _rev(cc), h0)
    xs, bm, cm, dtf, dtb = prep(u)
    _, y_f = _ssd_scan(xs, dtf, a[0], bm, cm, hf)
    _, y_b = _ssd_scan(_rev(xs), _rev(dtb), a[1], _rev(bm), _rev(cm), hb)
    out = finish(u, xs, y_f + _rev(y_b))
    out_c = finish(uc, xc, yc_f + _rev(yc_b)) if need_ctx else None
    return out, out_c


def _merge(h, outs, w_gate, b_gate, w_branch, w_out):
    gates = jax.nn.sigmoid(h @ w_gate + b_gate).reshape(*h.shape[:-1], N_BRANCH, D_MODEL)
    proj = jnp.einsum('...nw,nwd->...nd', jnp.stack(outs, -2), w_branch)
    return jnp.sum(gates * proj, -2) @ w_out


def setup_inputs(seed: int = 0) -> dict:
    key = jax.random.key(seed)
    ks = jax.random.split(key, 24)
    f32 = jnp.float32

    def nrm(k, shape, scale):
        return jax.random.normal(k, shape, f32) * scale

    x = nrm(ks[0], (BATCH, SEQ, D_MODEL), 1.0)
    c = nrm(ks[1], (BATCH, D_MODEL), 1.0)
    ctx = nrm(ks[2], (BATCH, CTX_LEN, D_MODEL), 1.0)
    c_ctx = nrm(ks[3], (D_MODEL,), 1.0)
    w_mod = nrm(ks[4], (DEPTH, D_MODEL, 3 * D_MODEL), 0.5 * D_MODEL ** -0.5)
    b_mod = nrm(ks[5], (DEPTH, 3 * D_MODEL), 0.02)
    g_pre = 1.0 + nrm(ks[6], (DEPTH, D_MODEL), 0.02)
    w_in = nrm(ks[7], (DEPTH, D_MODEL, N_IN), D_MODEL ** -0.5)
    w_gate = nrm(ks[8], (DEPTH, D_MODEL, N_BRANCH * D_MODEL), D_MODEL ** -0.5)
    b_gate = nrm(ks[9], (DEPTH, N_BRANCH * D_MODEL), 0.02)
    att_sink = nrm(ks[10], (DEPTH, ATT_HEADS), 0.5)
    f_init = jnp.linspace(ML_F_BIAS_LO, ML_F_BIAS_HI, ML_HEADS, dtype=f32)
    zero_h = jnp.zeros((ML_HEADS,), f32)
    ml_gate_bias = (nrm(ks[11], (DEPTH, 4, ML_HEADS), 0.1)
                    + jnp.stack([zero_h, f_init, zero_h, f_init])[None])
    ml_norm = 1.0 + nrm(ks[12], (DEPTH, ML_W), 0.02)
    ssm_conv_w = nrm(ks[13], (DEPTH, SSM_CONV, SSM_CONV_CH), SSM_CONV ** -0.5)
    ssm_conv_b = nrm(ks[14], (DEPTH, SSM_CONV_CH), 0.02)
    dt0 = jnp.exp(jax.random.uniform(ks[15], (DEPTH, 2, SSM_HEADS), f32,
                                     math.log(1e-3), math.log(1e-1)))
    ssm_dt_bias = dt0 + jnp.log(-jnp.expm1(-dt0))
    ssm_a_log = jnp.log(jax.random.uniform(ks[16], (DEPTH, 2, SSM_HEADS), f32, 1.0, 16.0))
    ssm_d = 1.0 + nrm(ks[17], (DEPTH, SSM_HEADS), 0.1)
    ssm_norm = 1.0 + nrm(ks[18], (DEPTH, SSM_W), 0.02)
    w_branch = nrm(ks[19], (DEPTH, N_BRANCH, BRANCH_W, D_MODEL), BRANCH_W ** -0.5)
    w_out = nrm(ks[20], (DEPTH, D_MODEL, D_MODEL), D_MODEL ** -0.5)
    g_post = 1.0 + nrm(ks[21], (DEPTH, D_MODEL), 0.02)
    return {'x': x, 'c': c, 'ctx': ctx, 'c_ctx': c_ctx, 'w_mod': w_mod, 'b_mod': b_mod,
            'g_pre': g_pre, 'w_in': w_in, 'w_gate': w_gate, 'b_gate': b_gate,
            'att_sink': att_sink, 'ml_gate_bias': ml_gate_bias, 'ml_norm': ml_norm,
            'ssm_conv_w': ssm_conv_w, 'ssm_conv_b': ssm_conv_b, 'ssm_dt_bias': ssm_dt_bias,
            'ssm_a_log': ssm_a_log, 'ssm_d': ssm_d, 'ssm_norm': ssm_norm,
            'w_branch': w_branch, 'w_out': w_out, 'g_post': g_post}


def reference(x, c, ctx, c_ctx, w_mod, b_mod, g_pre, w_in, w_gate, b_gate, att_sink,
              ml_gate_bias, ml_norm, ssm_conv_w, ssm_conv_b, ssm_dt_bias, ssm_a_log, ssm_d,
              ssm_norm, w_branch, w_out, g_post):
    seq = x.shape[1]
    rows = seq // GRID_W
    row = jnp.repeat(jnp.arange(rows), GRID_W)
    col = jnp.tile(jnp.arange(GRID_W), rows)
    cos, sin = _axial_rope_tables(row, col)
    xc = ctx
    sc = jax.nn.silu(c)
    scc = jax.nn.silu(c_ctx)
    for l in range(DEPTH):
        need_ctx = l < DEPTH - 1
        mod = sc @ w_mod[l] + b_mod[l]
        mod_c = scc @ w_mod[l] + b_mod[l]
        shift, scale, gate = jnp.split(mod[:, None, :], 3, axis=-1)
        shift_c, scale_c, gate_c = jnp.split(mod_c, 3, axis=-1)
        h = _rmsnorm(x, g_pre[l]) * (1.0 + scale) + shift
        hc = _rmsnorm(xc, g_pre[l]) * (1.0 + scale_c) + shift_c
        u = _split_cols(h @ w_in[l])
        uc = _split_cols(hc @ w_in[l])
        o_a, o_a_c = _attention_branch(u, uc, att_sink[l], cos, sin, need_ctx)
        o_m, o_m_c = _mlstm_branch(u, uc, ml_gate_bias[l], ml_norm[l], need_ctx)
        o_s, o_s_c = _ssd_branch(u, uc, ssm_conv_w[l], ssm_conv_b[l], ssm_dt_bias[l],
                                 ssm_a_log[l], ssm_d[l], ssm_norm[l], need_ctx)
        y = _merge(h, (o_a, o_m, o_s), w_gate[l], b_gate[l], w_branch[l], w_out[l])
        x = x + gate * _rmsnorm(y, g_post[l])
        if need_ctx:
            yc = _merge(hc, (o_a_c, o_m_c, o_s_c), w_gate[l], b_gate[l], w_branch[l], w_out[l])
            xc = xc + gate_c * _rmsnorm(yc, g_post[l])
    return x
```

```cpp
#include <hip/hip_runtime.h>
#include <cstdio>
#include <cstdint>

#ifndef MK_N_LAUNCHES
#define MK_N_LAUNCHES 1
#endif

#ifndef MK_DUP
#define MK_DUP -1
#endif
#define GAS __attribute__((address_space(1)))
typedef unsigned short bf16;
typedef unsigned v4u __attribute__((ext_vector_type(4)));
typedef unsigned v2u __attribute__((ext_vector_type(2)));
typedef float f32x4 __attribute__((ext_vector_type(4)));
typedef float f32x2 __attribute__((ext_vector_type(2)));
typedef short bf16x8 __attribute__((ext_vector_type(8)));

constexpr int DM = 2048, NBATCH = 16, SEQ = 2048, CTXL = 256, RB = SEQ + CTXL;
constexpr int NBP = 4, NPASS = NBATCH / NBP, RP = NBP * RB;
constexpr int NMT = RP / 256;
constexpr float EPS = 1e-6f;
constexpr int NU = 16384;
constexpr int UQ = 0, UK = 1024, UV = 1280, UAZ = 1536, UMQ = 2560, UMK = 3584, UMV = 4608, UMO = 5632, UMZ = 6656, UXBC = 7680, USZ = 9216, UG = 10240;
constexpr int N1 = 16640;
constexpr int USL = 64;
constexpr int NIN = 10288;

constexpr size_t MiB = 1u << 20;
constexpr size_t WS_CTL = 0, CTL_ZERO_BYTES = 1 * MiB;
constexpr size_t WS_MOD = 1 * MiB;
constexpr size_t WS_ROPE = 2 * MiB;
constexpr int LDK = 2048 + 64, LDK3 = 3072 + 64;
constexpr size_t WS_W1T = 4 * MiB;
constexpr size_t WS_WBT = 140 * MiB;
constexpr size_t WS_WOT = 166 * MiB;
constexpr size_t WS_HB = 184 * MiB;
constexpr size_t WS_U = 222 * MiB;
constexpr size_t WS_US = 510 * MiB;
constexpr size_t WS_SC = 514 * MiB;
constexpr size_t WS_OBR = 658 * MiB;
constexpr size_t WS_MG = 714 * MiB;
constexpr size_t WS_Y = 752 * MiB;
constexpr size_t WS_XC = 824 * MiB;
constexpr size_t WS_MSC = 852 * MiB;
constexpr size_t WS_SSC = 854 * MiB;
constexpr size_t WS_QK = 860 * MiB;
constexpr size_t WS_HB2 = 884 * MiB;
constexpr int LD8 = 2048 + 128;
constexpr size_t WS_HB8 = 922 * MiB;
constexpr size_t WS_WG8 = 962 * MiB;
constexpr float WG8_SCALE = 128.0f;
constexpr size_t WS_END = 988 * MiB;
static_assert(WS_W1T + (size_t)2 * N1 * LDK * 2 <= WS_WBT && WS_WBT + (size_t)2 * 2048 * LDK3 * 2 <= WS_WOT && WS_WOT + (size_t)2 * 2048 * LDK * 2 <= WS_HB && WS_HB + (size_t)RP * LDK * 2 <= WS_U && WS_U + (size_t)RP * NU * 2 <= WS_US &&
              WS_SC + (size_t)4 * RP * 1024 * 4 <= WS_OBR && WS_OBR + (size_t)RP * LDK3 * 2 <= WS_MG && WS_MG + (size_t)RP * LDK * 2 <= WS_Y && WS_Y + (size_t)RP * 2048 * 4 <= WS_XC && WS_XC + (size_t)RP * 1536 * 2 <= WS_MSC &&
              WS_MSC + (size_t)NBP * 8 * 36 * 384 * 4 <= WS_SSC && WS_SSC + (size_t)NBP * 2 * 36 * 16 * 320 * 4 <= WS_QK && WS_QK + (size_t)RP * 1280 * 2 <= WS_HB2 && WS_HB2 + (size_t)RP * LDK * 2 <= WS_END, "ws map");
constexpr int CW_BAR = 4096;
constexpr int CW_DONE = 32768;
constexpr int CW_QUEUE8 = 65536;
constexpr int CW_QUEUE = 16384;

constexpr int RING_BYTES = 131072;
constexpr int LDS_BYTES = 147456;
constexpr int MISC_OFF = LDS_BYTES - 256;

__device__ __forceinline__ unsigned pk2(float lo, float hi) { unsigned r; asm("v_cvt_pk_bf16_f32 %0, %1, %2" : "=v"(r) : "v"(lo), "v"(hi)); return r; }
__device__ __forceinline__ unsigned f2bf(float f) { return pk2(f, 0.f) & 0xffffu; }
__device__ __forceinline__ float bf2f(bf16 h) { return __builtin_bit_cast(float, (unsigned)h << 16); }
__device__ __forceinline__ float bflo(unsigned w) { return __builtin_bit_cast(float, w << 16); }
__device__ __forceinline__ float bfhi(unsigned w) { return __builtin_bit_cast(float, w & 0xffff0000u); }
__device__ __forceinline__ int lane4_l() { int ln = __builtin_amdgcn_mbcnt_hi(-1, __builtin_amdgcn_mbcnt_lo(-1, 0)) << 2; asm volatile("" : "+v"(ln)); return ln; }
__device__ __forceinline__ float bperm_f(int addr4, float v) { return __builtin_bit_cast(float, __builtin_amdgcn_ds_bpermute(addr4, __builtin_bit_cast(int, v))); }
__device__ __forceinline__ float shx(float v, int mask) { return bperm_f(lane4_l() ^ (mask << 2), v); }
__device__ __forceinline__ float shup(float v, int d) { const int l4 = lane4_l(); return bperm_f(l4 >= (d << 2) ? l4 - (d << 2) : l4, v); }
__device__ __forceinline__ float shidx(float v, int src) { return bperm_f(src << 2, v); }
__device__ __forceinline__ float wave_sum(float v) {
    const int l4 = lane4_l();
#pragma unroll
    for (int o = 1; o < 64; o <<= 1) v += bperm_f(l4 ^ (o << 2), v);
    return v;
}
__device__ __forceinline__ float wave_max(float v) {
    const int l4 = lane4_l();
#pragma unroll
    for (int o = 1; o < 64; o <<= 1) v = fmaxf(v, bperm_f(l4 ^ (o << 2), v));
    return v;
}
__device__ __forceinline__ float sigmoid_f(float x) { return 1.0f / (1.0f + expf(-x)); }
__device__ __forceinline__ float silu_f(float x) { return x / (1.0f + expf(-x)); }
__device__ __forceinline__ float softplus_f(float x) { return fmaxf(x, 0.f) + log1pf(expf(-fabsf(x))); }
__device__ __forceinline__ float logsigmoid_f(float x) { return -softplus_f(-x); }
__device__ __forceinline__ size_t ws_hb(int pass) { return (pass & 1) ? WS_HB2 : WS_HB; }
__device__ __forceinline__ size_t ws_hb8(int pass) { return WS_HB8 + ((pass & 1) ? 20 * MiB : 0); }
static_assert((size_t)RP * LD8 <= 20 * MiB && WS_HB8 + 40 * MiB <= WS_WG8 && WS_WG8 + (size_t)2 * 6144 * LD8 <= WS_END, "fp8 ws map");
__device__ __forceinline__ float fsig(float x) { return __builtin_amdgcn_rcpf(1.0f + __builtin_amdgcn_exp2f(-1.44269504f * x)); }
__device__ __forceinline__ float ex2(float x) { return __builtin_amdgcn_exp2f(x); }
constexpr float L2E = 1.44269504088896f;

struct Args { const float* in[22]; float* out; unsigned char* ws; int ph_lo, ph_hi; };
typedef const __attribute__((address_space(4))) Args KArgs;

#define XB_TMO      128
#define XB_XCNT(j)  (256  + 64 * (j))
#define XB_XSUB(j)  (1280 + 64 * (j))
#define XB_XGEN(j)  (2304 + 64 * (j))
#define XB_TOP      3328
#define XB_TOPGEN   3392
#define XCD_BAR_WORDS 3456
#define XB_SPIN_CAP (1u << 25)
#define LAS __attribute__((address_space(3)))

__device__ __forceinline__ unsigned xb_ld(unsigned* p)              { return __hip_atomic_load(p, __ATOMIC_RELAXED, __HIP_MEMORY_SCOPE_AGENT); }
__device__ __forceinline__ unsigned xb_add(unsigned* p, unsigned v) { return __hip_atomic_fetch_add(p, v, __ATOMIC_RELAXED, __HIP_MEMORY_SCOPE_AGENT); }
__device__ __forceinline__ unsigned xb_xcc_id() { return (unsigned)__builtin_amdgcn_s_getreg((3 << 11) | 20) & 0xFu; }
#define XB_SPIN(cond, bar) do { unsigned _sp = 0; while (cond) { __builtin_amdgcn_s_sleep(1); \
    if ((++_sp & 255u) == 0u) { if (xb_ld(&(bar)[XB_TMO])) break; if (_sp > XB_SPIN_CAP) { atomicAdd(&(bar)[XB_TMO], 1u); break; } } } } while (0)

struct XcdBarrier {
    unsigned* bar; unsigned x;
    volatile LAS unsigned* st;
};

__device__ __forceinline__ XcdBarrier xcd_barrier_post(unsigned* bar, volatile LAS unsigned* st) {
    XcdBarrier b; b.bar = bar; b.x = xb_xcc_id(); b.st = st;
    if (threadIdx.x == 0) (void)xb_add(&bar[XB_XCNT(b.x)], 1u);
    return b;
}
__device__ __forceinline__ void xcd_barrier_complete(unsigned* bar, unsigned x, unsigned& nloc, unsigned& nx) {
    const unsigned G = gridDim.x * gridDim.y * gridDim.z;
    unsigned sum, cnt, mine, sp = 0u;
    for (;;) {
        sum = 0u; cnt = 0u; mine = 0u;
#pragma unroll
        for (unsigned j = 0; j < 16; ++j) { const unsigned c = xb_ld(&bar[XB_XCNT(j)]); sum += c; cnt += (c > 0u) ? 1u : 0u; mine = (j == x) ? c : mine; }
        if (sum == G) break;
        __builtin_amdgcn_s_sleep(1);
        if ((++sp & 255u) == 0u) { if (xb_ld(&bar[XB_TMO])) break; if (sp > XB_SPIN_CAP) { atomicAdd(&bar[XB_TMO], 1u); break; } }
    }
    nloc = mine > 0u ? mine : 1u; nx = cnt > 0u ? cnt : 1u;
}

__device__ __forceinline__ void xcd_barrier(const XcdBarrier& b) {
    asm volatile("s_waitcnt vmcnt(0)" ::: "memory");
    __syncthreads();
    if (threadIdx.x == 0) {
        unsigned* bar = b.bar;
        __builtin_amdgcn_s_waitcnt(0);
        unsigned nloc = b.st[0], nx = b.st[1];
        if (nloc == 0u) { xcd_barrier_complete(bar, b.x, nloc, nx); b.st[0] = nloc; b.st[1] = nx; }
        const unsigned old = xb_add(&bar[XB_XSUB(b.x)], 1u);
        const unsigned gen = old / nloc;
        if (old + 1u == (gen + 1u) * nloc) {
            __builtin_amdgcn_fence(__ATOMIC_RELEASE, "agent");
            asm volatile("s_waitcnt vmcnt(0)" ::: "memory");
            const unsigned og = xb_add(&bar[XB_TOP], 1u);
            const unsigned tg = og / nx;
            if (og + 1u == (tg + 1u) * nx) xb_add(&bar[XB_TOPGEN], 1u);
            else XB_SPIN(xb_ld(&bar[XB_TOPGEN]) == tg, bar);
            __builtin_amdgcn_fence(__ATOMIC_ACQUIRE, "agent");
            xb_add(&bar[XB_XGEN(b.x)], 1u);
            asm volatile("s_waitcnt vmcnt(0)" ::: "memory");
        } else {
            XB_SPIN(xb_ld(&bar[XB_XGEN(b.x)]) == gen, bar);
            __builtin_amdgcn_fence(__ATOMIC_ACQUIRE, "agent");
            asm volatile("s_waitcnt vmcnt(0)" ::: "memory");
        }
    }
    __syncthreads();
}


namespace pg8 {
#define PG8_LAS __attribute__((address_space(3)))
typedef unsigned short bf16_t;
typedef short bf16x8 __attribute__((ext_vector_type(8)));
typedef float f32x4 __attribute__((ext_vector_type(4)));
typedef unsigned u32x4 __attribute__((ext_vector_type(4)));
typedef long v2l_t __attribute__((ext_vector_type(2)));
constexpr int BM = 256, BK = 64, HALF = 128, HTB = HALF * BK * 2  , STAGE_BYTES = 8 * HTB, NXCD = 8, WGM = 8;

__host__ __device__ __forceinline__ int lds_byte(int r, int c) { const int st = (r >> 4) * 2 + (c >> 5), rr = r & 15, cc = c & 31, ob = rr * 64 + cc * 2; return st * 1024 + (ob ^ (((ob >> 9) & 1) << 5)); }
__host__ __device__ __forceinline__ void stage_rc(int b, int& R, int& C) { const int st = b / 1024, sb = b % 1024, swz = sb ^ (((sb >> 9) & 1) << 5); R = (st >> 1) * 16 + swz / 64; C = (st & 1) * 32 + (swz % 64) / 2; }
__host__ __device__ __forceinline__ int perm32(int rho) { const int n = rho >> 4, i = rho & 15; return 8 * (i >> 2) + 4 * n + (i & 3); }

struct Unit { int pm, pn; };
struct Gemm { const bf16_t* A; const bf16_t* Bt; int M, N, K, ld; };

__device__ __forceinline__ void rect_map(int L, int nM, int nN, int& pm, int& pn) {
    const int nwg = nM * nN; int wgid = L;
    { const int q = nwg / NXCD, r = nwg % NXCD, xcd = wgid % NXCD, off = wgid / NXCD; wgid = (xcd < r ? xcd * (q + 1) : r * (q + 1) + (xcd - r) * q) + off; }
    const int nig = WGM * nN, gid = wgid / nig, fm = gid * WGM, gsz = (nM - fm) < WGM ? (nM - fm) : WGM;
    pm = fm + ((wgid % nig) % gsz); pn = (wgid % nig) / gsz;
}
__device__ __forceinline__ int main_tile(int m) { return (m >> 3) * 9 + 1 + (m & 7); }
__device__ __forceinline__ int colA(int i) { return i < 22 ? i : (i < 28 ? i + 8 : 64); }
__device__ __forceinline__ int colB(int i) { return i < 8 ? 22 + i : 28 + i; }
struct TileOrder {
    int nM1, nN1, mo1, special1;
    int nM2, nN2, mo2, pn_off2;
    int lim2;
    int G, c;
    __device__ __forceinline__ bool next(int i, Unit& u) const {
        const int L = i * G + c, n1 = nM1 * nN1;
        if (L < n1) { int pm, pn; rect_map(L, nM1, nN1, pm, pn); u.pm = mo1 ? main_tile(pm) : pm; u.pn = special1 ? colA(pn) : pn; return true; }
        if (L < n1 + lim2) { int pm, pn; rect_map(L - n1, nM2, nN2, pm, pn); u.pm = mo2 ? main_tile(pm) : pm; u.pn = (pn_off2 < 0) ? colB(pn) : pn + pn_off2; return true; }
        return false;
    }
    __device__ __forceinline__ void a_ready(const Unit&) const {}
    __device__ __forceinline__ void done(const Unit&) const {}
};

__device__ __forceinline__ void pos_map(int wgid, int nM, int nN, int& pm, int& pn) {
    const int nig = WGM * nN, gid = wgid / nig, fm = gid * WGM, gsz = (nM - fm) < WGM ? (nM - fm) : WGM;
    pm = fm + ((wgid % nig) % gsz); pn = (wgid % nig) / gsz;
}
__device__ __forceinline__ int chunk_lo(int x, int nwg) { const int q = nwg / NXCD, r = nwg % NXCD; return x * q + (x < r ? x : r); }
struct QueueOrder {
    unsigned* ctr8; int xcc;
    int nMb, mob, Lb0;
    int nMg, mog, L0;
    int first; volatile PG8_LAS int* slots;
    __device__ __forceinline__ int skip(int x) const { return (L0 - x + NXCD - 1) / NXCD; }
    __device__ __forceinline__ int skipb(int x) const { return (Lb0 - x + NXCD - 1) / NXCD; }
    __device__ __forceinline__ int draw() const {
        const int nb = nMb * 12, ng = nMg * 24;
        for (int k = 0; k < NXCD; ++k) { const int x = (xcc + k) & (NXCD - 1);
            const int t = (int)__hip_atomic_fetch_add(ctr8 + 64 * x, 1u, __ATOMIC_RELAXED, __HIP_MEMORY_SCOPE_AGENT);
            const int cb = chunk_lo(x + 1, nb) - chunk_lo(x, nb), sb = (skipb(x) < cb) ? skipb(x) : cb;
            if (t < cb - sb) return chunk_lo(x, nb) + sb + t;
            const int tg = t - (cb - sb) + skip(x);
            if (tg < chunk_lo(x + 1, ng) - chunk_lo(x, ng)) return nb + chunk_lo(x, ng) + tg; }
        return 0x3fffffff;
    }
    __device__ __forceinline__ bool next(int i, Unit& u) const {
        int P;
        if (i == 0) P = first;
        else { P = slots[i & 3]; if (threadIdx.x == 0) slots[(i + 1) & 3] = draw(); }
        P = __builtin_amdgcn_readfirstlane(P);
        const int nb = nMb * 12;
        if (P >= nb + nMg * 24) return false;
        int pm, pn;
        if (P < nb) { pos_map(P, nMb, 12, pm, pn); u.pm = mob ? main_tile(pm) : pm; u.pn = colB(pn); }
        else { pos_map(P - nb, nMg, 24, pm, pn); u.pm = mog ? main_tile(pm) : pm; u.pn = 40 + pn; }
        return true;
    }
    __device__ __forceinline__ void a_ready(const Unit&) const {}
    __device__ __forceinline__ void done(const Unit&) const {}
};

__device__ __forceinline__ unsigned cvt_pk_bf16(float lo, float hi) { unsigned r; asm volatile("v_cvt_pk_bf16_f32 %0, %1, %2" : "=v"(r) : "v"(lo), "v"(hi)); return r; }
__device__ __forceinline__ float fast_sigmoid(float x) { return __builtin_amdgcn_rcpf(1.0f + __builtin_amdgcn_exp2f(-1.44269504f * x)); }

typedef unsigned u32x2 __attribute__((ext_vector_type(2)));
__device__ __forceinline__ u32x2* gate_img(const bf16_t* U, int pm, int pn, int wid, int slot, int lane) {
    return (u32x2*)((unsigned char*)((bf16_t*)U + (size_t)(pm * BM + 2 * (wid * 16 + slot) + (lane >> 5)) * NU + pn * BM) + (lane & 31) * 8);
}
__device__ __forceinline__ float gate_q1(float g) { return __builtin_rintf(fmaxf(g * 255.0f, 1.0f)); }
__device__ __forceinline__ unsigned gate_q4(f32x4 g) {
    unsigned r = __builtin_amdgcn_cvt_pk_u8_f32(gate_q1(g[0]), 0u, 0u); r = __builtin_amdgcn_cvt_pk_u8_f32(gate_q1(g[1]), 1u, r);
    r = __builtin_amdgcn_cvt_pk_u8_f32(gate_q1(g[2]), 2u, r); return __builtin_amdgcn_cvt_pk_u8_f32(gate_q1(g[3]), 3u, r);
}
__device__ __forceinline__ f32x4 gate_c4(unsigned w) { return (f32x4){(float)(w & 0xffu), (float)((w >> 8) & 0xffu), (float)((w >> 16) & 0xffu), (float)(w >> 24)}; }
struct EpiC {
    static constexpr bool PERM = true, AFTER_DRAIN = false, MID = false; static constexpr int MID_T1 = -1, MID_T2 = -1;
    bf16_t* U; float* US; const float* bgate;
    __device__ __forceinline__ void operator()(const f32x4 (&acc)[2][2][4][2], const Unit& u, int wr, int wc, int fr, int fq) const {
        asm volatile("" : "+v"(fr), "+v"(fq));
        const int row0 = u.pm * BM + wr * 64 + fr;
        if (u.pn < 64) {
            const bool gate = u.pn >= 40; const float gsc = gate ? (1.0f / WG8_SCALE) : 1.0f;
            const int col0 = u.pn * BM + wc * 32 + 8 * fq;
            f32x4 bv[2][2];
#pragma unroll
            for (int bj = 0; bj < 2; ++bj)
#pragma unroll
                for (int n = 0; n < 2; ++n) bv[bj][n] = gate ? *(const f32x4*)(bgate + (col0 - 40 * BM) + bj * HALF + 4 * n) : (f32x4){0.f, 0.f, 0.f, 0.f};
#pragma unroll
            for (int ai = 0; ai < 2; ++ai)
#pragma unroll
                for (int m = 0; m < 4; ++m) { bf16_t* rowp = U + (size_t)(row0 + ai * HALF + m * 16) * NU + col0;
#pragma unroll
                    for (int bj = 0; bj < 2; ++bj) { f32x4 v0 = acc[ai][bj][m][0] * gsc + bv[bj][0], v1 = acc[ai][bj][m][1] * gsc + bv[bj][1];
                        if (gate) {
#pragma unroll
                            for (int j = 0; j < 4; ++j) { v0[j] = fast_sigmoid(v0[j]); v1[j] = fast_sigmoid(v1[j]); } }
                        if (gate) { u32x2 q; q.x = gate_q4(v0); q.y = gate_q4(v1); *gate_img(U, u.pm, u.pn, wr * 4 + wc, (ai * 4 + m) * 2 + bj, fq * 16 + fr) = q; }
                        else { u32x4 w; w.x = cvt_pk_bf16(v0[0], v0[1]); w.y = cvt_pk_bf16(v0[2], v0[3]); w.z = cvt_pk_bf16(v1[0], v1[1]); w.w = cvt_pk_bf16(v1[2], v1[3]); *(u32x4*)(rowp + bj * HALF) = w; } } }
        } else {
#pragma unroll
            for (int ai = 0; ai < 2; ++ai)
#pragma unroll
                for (int m = 0; m < 4; ++m) { float* rowp = US + (size_t)(row0 + ai * HALF + m * 16) * USL;
#pragma unroll
                    for (int n = 0; n < 2; ++n) { const int cc = wc * 32 + 8 * fq + 4 * n; if (cc < 48) *(f32x4*)(rowp + cc) = acc[ai][0][m][n]; } }
        }
    }
};

struct EpiF {
    static constexpr bool PERM = true, AFTER_DRAIN = false, MID = true; static constexpr int MID_T1 = 16, MID_T2 = 32;
    const bf16_t* U; bf16_t* MG; int skip_mid;
    __device__ __forceinline__ void mid(f32x4 (&acc)[2][2][4][2], const Unit& u, int t, int wr, int wc, int fr, int fq) const {
        const int seg = (t == MID_T1) ? 0 : 1;
        if (MK_DUP == 42 && skip_mid) return;
        asm volatile("" : "+v"(fr), "+v"(fq));
        const int row0 = u.pm * BM + wr * 64 + fr, col0 = u.pn * BM + wc * 32 + 8 * fq;
#pragma unroll
        for (int ai = 0; ai < 2; ++ai) {
#pragma unroll
            for (int m = 0; m < 4; ++m) { asm volatile("" ::: "memory");
#pragma unroll
                for (int bj = 0; bj < 2; ++bj) { const u32x2* gp = gate_img(U, u.pm, 40 + seg * 8 + u.pn, wr * 4 + wc, (ai * 4 + m) * 2 + bj, fq * 16 + fr);
                    const u32x2 ga = *gp, gb = *(const u32x2*)((const unsigned char*)gp + 2048 * 2);
                    const f32x4 a0 = gate_c4(ga.x), a1 = gate_c4(ga.y), b0 = gate_c4(gb.x), b1 = gate_c4(gb.y);
                    f32x4 r0, r1;
#pragma unroll
                    for (int j = 0; j < 4; ++j) { r0[j] = a0[j] * __builtin_amdgcn_rcpf(b0[j]); r1[j] = a1[j] * __builtin_amdgcn_rcpf(b1[j]); }
                    acc[ai][bj][m][0] *= r0; acc[ai][bj][m][1] *= r1; } }
        }
    }
    __device__ __forceinline__ void operator()(const f32x4 (&acc)[2][2][4][2], const Unit& u, int wr, int wc, int fr, int fq) const {
        asm volatile("" : "+v"(fr), "+v"(fq));
        const int row0 = u.pm * BM + wr * 64 + fr, col0 = u.pn * BM + wc * 32 + 8 * fq;
#pragma unroll
        for (int ai = 0; ai < 2; ++ai)
#pragma unroll
            for (int m = 0; m < 4; ++m) { const int row = row0 + ai * HALF + m * 16; bf16_t* op = MG + (size_t)row * LDK + col0;
#pragma unroll
                for (int bj = 0; bj < 2; ++bj) { const u32x2 g = *gate_img(U, u.pm, 56 + u.pn, wr * 4 + wc, (ai * 4 + m) * 2 + bj, fq * 16 + fr);
                    const f32x4 v0 = acc[ai][bj][m][0] * (gate_c4(g.x) * (1.0f / 255.0f)), v1 = acc[ai][bj][m][1] * (gate_c4(g.y) * (1.0f / 255.0f));
                    u32x4 w; w.x = cvt_pk_bf16(v0[0], v0[1]); w.y = cvt_pk_bf16(v0[2], v0[3]); w.z = cvt_pk_bf16(v1[0], v1[1]); w.w = cvt_pk_bf16(v1[2], v1[3]);
                    *(u32x4*)(op + bj * HALF) = w; } }
    }
};

struct EpiG {
    static constexpr bool PERM = true, AFTER_DRAIN = false, MID = false; static constexpr int MID_T1 = -1, MID_T2 = -1;
    bf16_t* C; int ldc;
    __device__ __forceinline__ void operator()(const f32x4 (&acc)[2][2][4][2], const Unit& u, int wr, int wc, int fr, int fq) const {
        asm volatile("" : "+v"(fr), "+v"(fq));
        const int row0 = u.pm * BM + wr * 64 + fr, col0 = u.pn * BM + wc * 32 + 8 * fq;
#pragma unroll
        for (int ai = 0; ai < 2; ++ai)
#pragma unroll
            for (int m = 0; m < 4; ++m) { bf16_t* rowp = C + (size_t)(row0 + ai * HALF + m * 16) * ldc + col0;
#pragma unroll
                for (int bj = 0; bj < 2; ++bj) { const f32x4 v0 = acc[ai][bj][m][0], v1 = acc[ai][bj][m][1];
                    u32x4 w; w.x = cvt_pk_bf16(v0[0], v0[1]); w.y = cvt_pk_bf16(v0[2], v0[3]); w.z = cvt_pk_bf16(v1[0], v1[1]); w.w = cvt_pk_bf16(v1[2], v1[3]);
                    *(u32x4*)(rowp + bj * HALF) = w; } }
    }
};

template <class Epi, class Sched, bool ALIGN_EPI = false, bool SP2 = false, bool FP8 = false>
__device__ __forceinline__ void gemm_phase(PG8_LAS unsigned char* lds, const Gemm g, const Sched& S, const Epi& E) {
    int tid_l = threadIdx.x; asm volatile("" : "+v"(tid_l));
    const int tid = tid_l, wid = __builtin_amdgcn_readfirstlane(tid >> 6), lane = tid & 63, wr = wid >> 2, wc = wid & 3, fr = lane & 15, fq = lane >> 4;
    const int K = g.K, nt = K / BK;
    unsigned voffA[2], voffB[2];
#pragma unroll
    for (int i = 0; i < 2; ++i) { int R, C; stage_rc(tid * 16 + i * 8192, R, C); const int Rb = Epi::PERM ? ((R & ~31) + perm32(R & 31)) : R;
        voffA[i] = (unsigned)(R * g.ld + C) * 2u; voffB[i] = (unsigned)(Rb * g.ld + C) * 2u; }
    const size_t kstep = (size_t)(BK * 2);
    const size_t hstep = (size_t)HALF * g.ld * 2;
    const size_t tstep = 2 * hstep;
    const unsigned ldsw = (unsigned)wid * 1024u;
    const int aoff = lds_byte(wr * 64 + fr, fq * 8), boff = lds_byte(wc * 32 + fr, fq * 8);
#define PG8_SA(b, h) (((b) * 2 + (h)) * HTB)
#define PG8_SB(b, h) ((4 + (b) * 2 + (h)) * HTB)
#define PG8_STAGE(bufoff, gbase, voff) do { _Pragma("unroll") for (int _i = 0; _i < 2; ++_i) \
        __builtin_amdgcn_global_load_lds((const unsigned*)((const char*)(gbase) + (voff)[_i]), (PG8_LAS unsigned*)(lds + (bufoff) + ldsw + _i * 8192), 16, 0, 0); } while (0)
#define PG8_LDA(dst, b, h) do { _Pragma("unroll") for (int m = 0; m < 4; ++m) _Pragma("unroll") for (int k = 0; k < 2; ++k) dst[m][k] = *(const PG8_LAS bf16x8*)(lds + PG8_SA(b, h) + aoff + m * 2048 + k * 1024); } while (0)
#define PG8_LDB(dst, b, h) do { _Pragma("unroll") for (int n = 0; n < 2; ++n) _Pragma("unroll") for (int k = 0; k < 2; ++k) dst[n][k] = *(const PG8_LAS bf16x8*)(lds + PG8_SB(b, h) + boff + n * 2048 + k * 1024); } while (0)
#define PG8_MMA(ai, bj, At, Bt) do { __builtin_amdgcn_s_setprio(1); _Pragma("unroll") for (int m = 0; m < 4; ++m) _Pragma("unroll") for (int n = 0; n < 2; ++n) _Pragma("unroll") for (int k = 0; k < 2; ++k) { \
        if constexpr (FP8) { const v2l_t bq = __builtin_bit_cast(v2l_t, Bt[n][k]), aq = __builtin_bit_cast(v2l_t, At[m][k]); \
            acc[ai][bj][m][n] = __builtin_amdgcn_mfma_f32_16x16x32_fp8_fp8(bq[0], aq[0], acc[ai][bj][m][n], 0, 0, 0); acc[ai][bj][m][n] = __builtin_amdgcn_mfma_f32_16x16x32_fp8_fp8(bq[1], aq[1], acc[ai][bj][m][n], 0, 0, 0); } \
        else acc[ai][bj][m][n] = __builtin_amdgcn_mfma_f32_16x16x32_bf16(Bt[n][k], At[m][k], acc[ai][bj][m][n], 0, 0, 0); } __builtin_amdgcn_s_setprio(0); } while (0)
#define PG8_WAIT_V(n) asm volatile("s_waitcnt vmcnt(" #n ")" ::: "memory")
#define PG8_WAIT_L(n) asm volatile("s_waitcnt lgkmcnt(" #n ")" ::: "memory")
#define PG8_BAR __builtin_amdgcn_s_barrier()
#define PG8_SCHED __builtin_amdgcn_sched_barrier(0)
    Unit cur, nxt; int ui = 0;
    if (!S.next(0, cur)) return;
    f32x4 acc[2][2][4][2];
#pragma unroll
    for (int a = 0; a < 2; ++a)
#pragma unroll
        for (int b = 0; b < 2; ++b)
#pragma unroll
            for (int m = 0; m < 4; ++m)
#pragma unroll
                for (int n = 0; n < 2; ++n) acc[a][b][m][n] = (f32x4){0.f, 0.f, 0.f, 0.f};
    bf16x8 At[4][2], B0[2][2], B1[2][2];
    const char* cA = (const char*)g.A + (size_t)cur.pm * tstep; const char* cB = (const char*)g.Bt + (size_t)cur.pn * tstep;
    S.a_ready(cur);
    if constexpr (SP2) {
        PG8_STAGE(PG8_SB(0, 0), cB, voffB); PG8_STAGE(PG8_SB(0, 1), cB + hstep, voffB); PG8_STAGE(PG8_SA(0, 0), cA, voffA); PG8_STAGE(PG8_SA(0, 1), cA + hstep, voffA);
        if (wr == 1) PG8_BAR;
        PG8_WAIT_V(2); PG8_BAR;
        PG8_STAGE(PG8_SB(1, 0), cB + kstep, voffB); PG8_STAGE(PG8_SA(1, 0), cA + kstep, voffA); PG8_STAGE(PG8_SB(1, 1), cB + hstep + kstep, voffB);
        PG8_WAIT_V(6); PG8_BAR;
    } else {
        PG8_STAGE(PG8_SB(0, 0), cB, voffB); PG8_STAGE(PG8_SA(0, 0), cA, voffA); PG8_STAGE(PG8_SB(0, 1), cB + hstep, voffB); PG8_STAGE(PG8_SA(0, 1), cA + hstep, voffA);
        if (wr == 1) PG8_BAR;
        PG8_WAIT_V(4); PG8_BAR;
        PG8_STAGE(PG8_SB(1, 0), cB + kstep, voffB); PG8_STAGE(PG8_SA(1, 0), cA + kstep, voffA); PG8_STAGE(PG8_SB(1, 1), cB + hstep + kstep, voffB);
        PG8_WAIT_V(6); PG8_BAR;
    }
    for (;;) {
        const bool has_next = S.next(ui + 1, nxt);
        const char* nA = has_next ? (const char*)g.A + (size_t)nxt.pm * tstep : cA; const char* nB = has_next ? (const char*)g.Bt + (size_t)nxt.pn * tstep : cB;
        const int tseg = Epi::MID ? Epi::MID_T1 : nt;
        for (int tb = 0; tb < nt; tb += tseg) {
        if constexpr (Epi::MID) { if (tb != 0) E.mid(acc, cur, tb, wr, wc, fr, fq); }
        for (int t = tb; t < tb + tseg; t += 2) {
            const bool last = (t == nt - 2);
            const char* a1 = cA + (size_t)(t + 1) * kstep;
            const char* a2 = last ? nA : cA + (size_t)(t + 2) * kstep; const char* b2 = last ? nB : cB + (size_t)(t + 2) * kstep;
            const char* a3 = a2 + kstep; const char* b3 = b2 + kstep;
            if (last && has_next) S.a_ready(nxt);

            if constexpr (SP2) {
            PG8_LDB(B0, 0, 0); PG8_LDB(B1, 0, 1); PG8_SCHED; PG8_LDA(At, 0, 0); PG8_STAGE(PG8_SA(1, 1), a1 + hstep, voffA);
            PG8_WAIT_V(8); PG8_WAIT_L(0); PG8_BAR; PG8_MMA(0, 0, At, B0); PG8_MMA(0, 1, At, B1); PG8_BAR; PG8_SCHED;
            PG8_LDA(At, 0, 1); PG8_STAGE(PG8_SB(0, 0), b2, voffB); PG8_STAGE(PG8_SB(0, 1), b2 + hstep, voffB); PG8_STAGE(PG8_SA(0, 0), a2, voffA);
            PG8_WAIT_V(8); PG8_WAIT_L(0); PG8_BAR; PG8_MMA(1, 0, At, B0); PG8_MMA(1, 1, At, B1); PG8_BAR; PG8_SCHED;
            PG8_LDB(B0, 1, 0); PG8_LDB(B1, 1, 1); PG8_SCHED; PG8_LDA(At, 1, 0); PG8_STAGE(PG8_SA(0, 1), a2 + hstep, voffA);
            PG8_WAIT_V(8); PG8_WAIT_L(0); PG8_BAR; PG8_MMA(0, 0, At, B0); PG8_MMA(0, 1, At, B1); PG8_BAR; PG8_SCHED;
            PG8_LDA(At, 1, 1); PG8_STAGE(PG8_SB(1, 0), b3, voffB); PG8_STAGE(PG8_SB(1, 1), b3 + hstep, voffB); PG8_STAGE(PG8_SA(1, 0), a3, voffA);
            PG8_WAIT_V(8); PG8_WAIT_L(0); PG8_BAR; PG8_MMA(1, 0, At, B0); PG8_MMA(1, 1, At, B1); PG8_BAR; PG8_SCHED;
            } else {
            PG8_LDB(B0, 0, 0); PG8_SCHED; PG8_LDA(At, 0, 0); PG8_STAGE(PG8_SA(1, 1), a1 + hstep, voffA);
            PG8_WAIT_L(8); PG8_BAR; PG8_WAIT_L(0); PG8_MMA(0, 0, At, B0); PG8_BAR; PG8_SCHED;
            PG8_LDB(B1, 0, 1); PG8_STAGE(PG8_SB(0, 0), b2, voffB);
            PG8_BAR; PG8_WAIT_L(0); PG8_MMA(0, 1, At, B1); PG8_BAR;
            PG8_LDA(At, 0, 1); PG8_STAGE(PG8_SA(0, 0), a2, voffA);
            PG8_BAR; PG8_WAIT_L(0); PG8_MMA(1, 0, At, B0); PG8_BAR; PG8_SCHED;
            PG8_STAGE(PG8_SB(0, 1), b2 + hstep, voffB);
            PG8_WAIT_V(6); PG8_BAR; PG8_MMA(1, 1, At, B1); PG8_BAR;
            PG8_LDB(B0, 1, 0); PG8_SCHED; PG8_LDA(At, 1, 0); PG8_STAGE(PG8_SA(0, 1), a2 + hstep, voffA);
            PG8_WAIT_L(8); PG8_BAR; PG8_WAIT_L(0); PG8_MMA(0, 0, At, B0); PG8_BAR; PG8_SCHED;
            PG8_LDB(B1, 1, 1); PG8_STAGE(PG8_SB(1, 0), b3, voffB);
            PG8_BAR; PG8_WAIT_L(0); PG8_MMA(0, 1, At, B1); PG8_BAR;
            PG8_LDA(At, 1, 1); PG8_STAGE(PG8_SA(1, 0), a3, voffA);
            PG8_BAR; PG8_WAIT_L(0); PG8_MMA(1, 0, At, B0); PG8_BAR; PG8_SCHED;
            PG8_STAGE(PG8_SB(1, 1), b3 + hstep, voffB);
            PG8_WAIT_V(6); PG8_BAR; PG8_MMA(1, 1, At, B1); PG8_BAR;
            }
        }
        }
        if constexpr (ALIGN_EPI) { if (wr == 0) PG8_BAR; }
        if constexpr (!Epi::AFTER_DRAIN) { E(acc, cur, wr, wc, fr, fq); S.done(cur); }
        if (!has_next) break;
#pragma unroll
        for (int a = 0; a < 2; ++a)
#pragma unroll
            for (int b = 0; b < 2; ++b)
#pragma unroll
                for (int m = 0; m < 4; ++m)
#pragma unroll
                    for (int n = 0; n < 2; ++n) acc[a][b][m][n] = (f32x4){0.f, 0.f, 0.f, 0.f};
        cur = nxt; cA = nA; cB = nB; ++ui;
        if constexpr (ALIGN_EPI) { if (wr == 1) PG8_BAR; }
    }
    PG8_WAIT_V(0);
    if constexpr (!ALIGN_EPI) { if (wr == 0) PG8_BAR; }
    PG8_BAR;
    if constexpr (Epi::AFTER_DRAIN) { E.fused(acc, cur, wr, wc, fr, fq, lds, wid, lane); S.done(cur); }
#undef PG8_SA
#undef PG8_SB
#undef PG8_STAGE
#undef PG8_LDA
#undef PG8_LDB
#undef PG8_MMA
#undef PG8_WAIT_V
#undef PG8_WAIT_L
#undef PG8_BAR
#undef PG8_SCHED
}
}

#define LDS_WAIT() asm volatile("s_waitcnt lgkmcnt(0)" ::: "memory")

__device__ __forceinline__ bool w1_src(KArgs& a, int l, int d, const float*& W, int& ldw, int& col) {
    const float* win = a.in[7] + (size_t)l * 2048 * NIN; const float* wg = a.in[8] + (size_t)l * 2048 * 6144;
    if (d < 7680) { W = win; ldw = NIN; col = d; return true; }
    if (d < 9216) { W = win; ldw = NIN; col = d + 16; return true; }
    if (d < 10240) { W = win; ldw = NIN; col = 9264 + (d - 9216); return true; }
    if (d < 16384) { W = wg; ldw = 6144; col = d - 10240; return true; }
    if (d < 16400) { W = win; ldw = NIN; col = 7680 + (d - 16384); return true; }
    if (d < 16432) { W = win; ldw = NIN; col = 9232 + (d - 16400); return true; }
    W = win; ldw = NIN; col = 0; return false;
}
__device__ __forceinline__ void p0_transpose_item(const float* Wc, int ldw, bool valid, int k0, bf16* dst, int dst_ld, int drow0, int dcol0, LAS float* scr, int lane, bool f8 = false) {
    f32x4 wv[8];
#pragma unroll
    for (int i = 0; i < 8; ++i) { const int kk = (lane >> 3) + 8 * i; wv[i] = valid ? *(const f32x4*)(Wc + (size_t)(k0 + kk) * ldw) : (f32x4){0.f, 0.f, 0.f, 0.f}; }
#pragma unroll
    for (int i = 0; i < 8; ++i) { const int kk = (lane >> 3) + 8 * i; LAS float* pw = scr + kk * 33 + 4 * (lane & 7); pw[0] = wv[i].x; pw[1] = wv[i].y; pw[2] = wv[i].z; pw[3] = wv[i].w; }
    LDS_WAIT(); asm volatile("" ::: "memory");
    const int c = lane & 7;
#pragma unroll
    for (int j = 0; j < 4; ++j) { const int n = (lane >> 3) + 8 * j; const LAS float* s = scr + (8 * c) * 33 + n;
        if (f8) { int q0 = __builtin_amdgcn_cvt_pk_fp8_f32(s[0 * 33] * WG8_SCALE, s[1 * 33] * WG8_SCALE, 0, false); q0 = __builtin_amdgcn_cvt_pk_fp8_f32(s[2 * 33] * WG8_SCALE, s[3 * 33] * WG8_SCALE, q0, true);
            int q1 = __builtin_amdgcn_cvt_pk_fp8_f32(s[4 * 33] * WG8_SCALE, s[5 * 33] * WG8_SCALE, 0, false); q1 = __builtin_amdgcn_cvt_pk_fp8_f32(s[6 * 33] * WG8_SCALE, s[7 * 33] * WG8_SCALE, q1, true);
            v2u o8; o8.x = (unsigned)q0; o8.y = (unsigned)q1; *(v2u*)((unsigned char*)dst + (size_t)(drow0 + n) * dst_ld + dcol0 + k0 + 8 * c) = o8; }
        else { v4u o; o.x = pk2(s[0 * 33], s[1 * 33]); o.y = pk2(s[2 * 33], s[3 * 33]); o.z = pk2(s[4 * 33], s[5 * 33]); o.w = pk2(s[6 * 33], s[7 * 33]);
            *(v4u*)(dst + (size_t)(drow0 + n) * dst_ld + dcol0 + k0 + 8 * c) = o; } }
    LDS_WAIT(); asm volatile("" ::: "memory");
}
__device__ __forceinline__ void p0_weights(KArgs& a, int l, LAS unsigned char* lds, int lane, int wave, int gw, int NGW) {
    LAS float* scr = (LAS float*)(lds + wave * 16384);
    constexpr int I_1 = 32 * 520, I_B = 3 * 16 * 64, I_O = 32 * 64, I_L = I_1 + I_B + I_O;
    for (int it = gw; it < I_L; it += NGW) {
        int r = it;
        if (r < I_1) { const int nb = r % 520, kb = r / 520; const float* W; int ldw, col; const bool ok = w1_src(a, l, nb * 32 + 4 * (lane & 7), W, ldw, col);
            if (nb >= 320 && nb < 512) p0_transpose_item(W + col, ldw, ok, kb * 64, (bf16*)(a.ws + WS_WG8 + (size_t)l * 6144 * LD8), LD8, (nb - 320) * 32, 0, scr, lane, true);
            else p0_transpose_item(W + col, ldw, ok, kb * 64, (bf16*)(a.ws + WS_W1T) + (size_t)l * N1 * LDK, LDK, nb * 32, 0, scr, lane);
            continue; }
        r -= I_1;
        if (r < I_B) { const int br = r / 1024, q = r % 1024, nb = q % 64, kb = q / 64; const float* W = a.in[19] + ((size_t)(l * 3 + br) * 1024) * 2048;
            p0_transpose_item(W + nb * 32 + 4 * (lane & 7), 2048, true, kb * 64, (bf16*)(a.ws + WS_WBT) + (size_t)l * 2048 * LDK3, LDK3, nb * 32, br * 1024, scr, lane); continue; }
        r -= I_B;
        { const int nb = r % 64, kb = r / 64; const float* W = a.in[20] + (size_t)l * 2048 * 2048;
            p0_transpose_item(W + nb * 32 + 4 * (lane & 7), 2048, true, kb * 64, (bf16*)(a.ws + WS_WOT) + (size_t)l * 2048 * LDK, LDK, nb * 32, 0, scr, lane); }
    }
}
__device__ __forceinline__ void phase_p0(KArgs& a, LAS unsigned char* lds, int tid, int lane, int wave, int G, int c) {
    {
        LAS float* sc = (LAS float*)lds;
        LAS float* red = sc + 17 * 1024;
        for (int u = c; u < 192; u += G) {
            const int l = u / 96, col0 = (u % 96) * 64, col = tid & 63, kg = tid >> 6;
            const float* W = a.in[4] + (size_t)l * 2048 * 6144;
            float acc[17];
#pragma unroll
            for (int b = 0; b < 17; ++b) acc[b] = 0.f;
            for (int kh = 0; kh < 2; ++kh) {
                __syncthreads();
                for (int i = tid; i < 17 * 1024; i += 512) { const int b = i >> 10, k = kh * 1024 + (i & 1023); const float v = (b < 16) ? a.in[1][b * 2048 + k] : a.in[3][k]; sc[i] = silu_f(v); }
                __syncthreads();
                for (int k8 = 0; k8 < 128; k8 += 16) { float w[16];
#pragma unroll
                    for (int j = 0; j < 16; ++j) w[j] = W[(size_t)(kh * 1024 + kg * 128 + k8 + j) * 6144 + col0 + col];
#pragma unroll
                    for (int j = 0; j < 16; ++j) { const int kl = kg * 128 + k8 + j;
#pragma unroll
                        for (int b = 0; b < 17; ++b) acc[b] += sc[b * 1024 + kl] * w[j]; } }
            }
#pragma unroll
            for (int b = 0; b < 17; ++b) red[(kg * 17 + b) * 64 + col] = acc[b];
            __syncthreads();
            float* MOD = (float*)(a.ws + WS_MOD) + (size_t)l * 17 * 6144;
            for (int i = tid; i < 17 * 64; i += 512) { const int b = i >> 6, cc = i & 63; float s = a.in[5][l * 6144 + col0 + cc];
#pragma unroll
                for (int g = 0; g < 8; ++g) s += red[(g * 17 + b) * 64 + cc];
                const int jm = col0 + cc;
                if (jm >= 4096) s *= a.in[21][l * 2048 + jm - 4096]; else if (jm >= 2048) s = a.in[6][l * 2048 + jm - 2048] * (s + 1.0f);
                MOD[b * 6144 + jm] = s; }
        }
        __syncthreads();
    }
    const int gw = c * 8 + wave, NGW = G * 8;
    {
        float* rc = (float*)(a.ws + WS_ROPE); float* rs = rc + 2048 * 64;
        for (int i = gw * 64 + lane; i < 2048 * 64; i += NGW * 64) { const int t = i >> 6, p = i & 63; const float inv = powf(10000.0f, -(float)(p & 31) / 32.0f);
            const float ang = (float)((p < 32) ? (t >> 6) : (t & 63)) * inv; rc[i] = cosf(ang); rs[i] = sinf(ang); }
    }
    p0_weights(a, 0, lds, lane, wave, gw, NGW);
}

#define COLK(k_) (512 * ((k_) >> 1) + 8 * lane + 4 * ((k_) & 1))
__device__ __forceinline__ void stage_mod(LAS float* dst, const float* mod_l, int part, int pass, int tid) {
    for (int u = tid; u < 5 * 512; u += 512) { const int r5 = u >> 9, w = u & 511, k = w >> 6, ln = w & 63; const int col = 512 * (k >> 1) + 8 * ln + 4 * (k & 1);
        const int mrow = (r5 == 4) ? 16 : pass * NBP + r5;
        *(LAS f32x4*)(dst + (size_t)u * 4) = *(const f32x4*)(mod_l + (size_t)mrow * 6144 + part * 2048 + col); }
}
#define MODV(base_, r5_, k_) (*(const LAS f32x4*)((base_) + (size_t)((((r5_) * 8 + (k_)) * 64 + lane) * 4)))
__device__ __forceinline__ void norm_mod_store(const f32x4 (&v)[8], const LAS float* SH, const LAS float* SC, int r5, bf16* dst, unsigned char* dst8, int lane) {
    float ss = 0.f;
#pragma unroll
    for (int k = 0; k < 8; ++k) ss += (v[k].x * v[k].x + v[k].y * v[k].y) + (v[k].z * v[k].z + v[k].w * v[k].w);
    ss = wave_sum(ss);
    const float rstd = 1.0f / sqrtf(ss * (1.0f / 2048.0f) + EPS);
    v4u w[4]; v2u w8[4];
#pragma unroll
    for (int j = 0; j < 4; ++j) {
        const f32x4 o0 = (v[2 * j] * rstd) * MODV(SC, r5, 2 * j) + MODV(SH, r5, 2 * j), o1 = (v[2 * j + 1] * rstd) * MODV(SC, r5, 2 * j + 1) + MODV(SH, r5, 2 * j + 1);
        w[j].x = pk2(o0.x, o0.y); w[j].y = pk2(o0.z, o0.w); w[j].z = pk2(o1.x, o1.y); w[j].w = pk2(o1.z, o1.w);
        int q0 = __builtin_amdgcn_cvt_pk_fp8_f32(o0.x, o0.y, 0, false); q0 = __builtin_amdgcn_cvt_pk_fp8_f32(o0.z, o0.w, q0, true);
        int q1 = __builtin_amdgcn_cvt_pk_fp8_f32(o1.x, o1.y, 0, false); q1 = __builtin_amdgcn_cvt_pk_fp8_f32(o1.z, o1.w, q1, true);
        w8[j].x = (unsigned)q0; w8[j].y = (unsigned)q1; }
#pragma unroll
    for (int j = 0; j < 4; ++j) { *(v4u*)(dst + COLK(2 * j)) = w[j]; *(v2u*)(dst8 + COLK(2 * j)) = w8[j]; }
}
__device__ __forceinline__ void phase_B(KArgs& a, int pass, LAS unsigned char* lds, int lane, int gw, int NGW) {
    LAS float* SH = (LAS float*)lds; LAS float* SC = SH + 5 * 2048;
    { const int tid = (gw & 7) * 64 + lane; const float* MOD0 = (const float*)(a.ws + WS_MOD); __syncthreads(); stage_mod(SH, MOD0, 0, pass, tid); stage_mod(SC, MOD0, 1, pass, tid); __syncthreads(); }
#define B_SRC(rl_) ((((rl_) % RB) < CTXL) ? a.in[2] + ((size_t)(pass * NBP + (rl_) / RB) * CTXL + ((rl_) % RB)) * 2048 : a.in[0] + ((size_t)(pass * NBP + (rl_) / RB) * SEQ + (((rl_) % RB) - CTXL)) * 2048)
    for (int rl = gw; rl < RP; rl += 2 * NGW) {
        const int rl2 = rl + NGW; const bool two = rl2 < RP;
        const float* s0 = B_SRC(rl); const float* s1 = two ? B_SRC(rl2) : s0;
        f32x4 v[8], v2[8];
#pragma unroll
        for (int k = 0; k < 8; ++k) v[k] = *(const f32x4*)(s0 + COLK(k));
        if (two) {
#pragma unroll
            for (int k = 0; k < 8; ++k) v2[k] = *(const f32x4*)(s1 + COLK(k)); }
        norm_mod_store(v, SH, SC, ((rl % RB) < CTXL) ? 4 : rl / RB, (bf16*)(a.ws + ws_hb(pass)) + (size_t)rl * LDK, a.ws + ws_hb8(pass) + (size_t)rl * LD8, lane);
        if (two) norm_mod_store(v2, SH, SC, ((rl2 % RB) < CTXL) ? 4 : rl2 / RB, (bf16*)(a.ws + ws_hb(pass)) + (size_t)rl2 * LDK, a.ws + ws_hb8(pass) + (size_t)rl2 * LD8, lane);
    }
#undef B_SRC
    __syncthreads();
}
__device__ __forceinline__ void phase_H(KArgs& a, int pass, int l, LAS unsigned char* lds, int lane, int gw, int NGW) {
    LAS float* GT = (LAS float*)lds; LAS float* SH = GT + 5 * 2048; LAS float* SC = SH + 5 * 2048;
    { const int tid = (gw & 7) * 64 + lane; const float* MODl = (const float*)(a.ws + WS_MOD) + (size_t)l * 17 * 6144; __syncthreads(); stage_mod(GT, MODl, 2, pass, tid);
      if (l == 0) { stage_mod(SH, MODl + 17 * 6144, 0, pass, tid); stage_mod(SC, MODl + 17 * 6144, 1, pass, tid); } __syncthreads(); }
    const bf16* Y = (const bf16*)(a.ws + WS_Y);
    const int nrows = (l == 0) ? RP : NBP * SEQ;
#define H_ROW(i_) ((l == 0) ? (i_) : (((i_) / SEQ) * RB + CTXL + ((i_) % SEQ)))
#define H_SRC(rl_, xo_) do { const int b_ = pass * NBP + (rl_) / RB, j_ = (rl_) % RB; \
        xo_ = (l == 0) ? ((j_ < CTXL) ? a.in[2] + ((size_t)b_ * CTXL + j_) * 2048 : a.in[0] + ((size_t)b_ * SEQ + (j_ - CTXL)) * 2048) : a.out + ((size_t)b_ * SEQ + (j_ - CTXL)) * 2048; } while (0)
    v4u ywn[4]; f32x4 xnn[8];
    if (gw < nrows) { const int rl = H_ROW(gw); const float* xo; H_SRC(rl, xo); const bf16* yr = Y + (size_t)rl * 2048;
#pragma unroll
        for (int j = 0; j < 4; ++j) ywn[j] = *(const v4u*)(yr + COLK(2 * j));
#pragma unroll
        for (int k = 0; k < 8; ++k) xnn[k] = *(const f32x4*)(xo + COLK(k)); }
    for (int i = gw; i < nrows; i += NGW) {
        const int rl = H_ROW(i), b = pass * NBP + rl / RB, j = rl % RB; const bool is_ctx = j < CTXL;
        float* orow = a.out + ((size_t)b * SEQ + (is_ctx ? 0 : (j - CTXL))) * 2048;
        const int r5 = is_ctx ? 4 : rl / RB;
        f32x4 y[8], xn[8]; v4u yw[4]; float ss = 0.f;
#pragma unroll
        for (int jj = 0; jj < 4; ++jj) yw[jj] = ywn[jj];
#pragma unroll
        for (int k = 0; k < 8; ++k) xn[k] = xnn[k];
        if (i + NGW < nrows) { const int rl2 = H_ROW(i + NGW); const float* xo2; H_SRC(rl2, xo2); const bf16* yr2 = Y + (size_t)rl2 * 2048;
#pragma unroll
            for (int jj = 0; jj < 4; ++jj) ywn[jj] = *(const v4u*)(yr2 + COLK(2 * jj));
#pragma unroll
            for (int k = 0; k < 8; ++k) xnn[k] = *(const f32x4*)(xo2 + COLK(k)); }
#pragma unroll
        for (int jj = 0; jj < 4; ++jj) { y[2 * jj] = (f32x4){bflo(yw[jj].x), bfhi(yw[jj].x), bflo(yw[jj].y), bfhi(yw[jj].y)}; y[2 * jj + 1] = (f32x4){bflo(yw[jj].z), bfhi(yw[jj].z), bflo(yw[jj].w), bfhi(yw[jj].w)}; }
#pragma unroll
        for (int k = 0; k < 8; ++k) ss += (y[k].x * y[k].x + y[k].y * y[k].y) + (y[k].z * y[k].z + y[k].w * y[k].w);
        ss = wave_sum(ss);
        const float rstd = 1.0f / sqrtf(ss * (1.0f / 2048.0f) + EPS);
#pragma unroll
        for (int k = 0; k < 8; ++k) xn[k] = xn[k] + MODV(GT, r5, k) * (y[k] * rstd);
        if (!is_ctx) {
#pragma unroll
            for (int k = 0; k < 8; ++k) *(f32x4*)(orow + COLK(k)) = xn[k]; }
        if (l == 0) norm_mod_store(xn, SH, SC, r5, (bf16*)(a.ws + ws_hb(pass)) + (size_t)rl * LDK, a.ws + ws_hb8(pass) + (size_t)rl * LD8, lane);
    }
#undef H_ROW
#undef H_SRC
    __syncthreads();
}

__device__ __forceinline__ int scan_row(int step, int dir) {
    if (dir == 0) return step;
    return step < CTXL ? (CTXL - 1 - step) : (RB - 1 - (step - CTXL));
}
__device__ __forceinline__ void mlstm_simple_unit(KArgs& a, int l, int unit, LAS unsigned char* ldsb, int tid) {
    const int es = unit & 3, dir = (unit >> 2) & 1, head = (unit >> 3) & 3, bl = unit >> 5;
    const int lane = tid & 63, dg = tid >> 6, e = lane;
    LAS float* qs = (LAS float*)ldsb; LAS float* ks = qs + 256; LAS float* vs = ks + 256; LAS float* part = vs + 64; LAS float* qnp = part + 512;
    const bf16* U = (const bf16*)(a.ws + WS_U) + (size_t)bl * RB * NU;
    const float* US = (const float*)(a.ws + WS_US) + (size_t)bl * RB * USL;
    float* H = (float*)(a.ws + WS_SC) + (size_t)dir * RP * 1024 + (size_t)bl * RB * 1024;
    const float gbi = a.in[11][l * 16 + (dir * 2) * 4 + head], gbf = a.in[11][l * 16 + (dir * 2 + 1) * 4 + head];
    float C[32];
#pragma unroll
    for (int i = 0; i < 32; ++i) C[i] = 0.f;
    float nn = 0.f, m = 0.f, pq = 0.f, pk = 0.f, pv = 0.f, pgi = 0.f, pgf = 0.f;
    int j = scan_row(0, dir);
#define ML_LOAD(jj) do { const bf16* ur = U + (size_t)(jj) * NU; if (tid < 256) { pq = bf2f(ur[UMQ + head * 256 + tid]); pk = bf2f(ur[UMK + head * 256 + tid]) * 0.0625f; } \
        else if (tid < 320) pv = bf2f(ur[UMV + head * 256 + es * 64 + tid - 256]); \
        pgi = US[(size_t)(jj) * USL + (dir * 2) * 4 + head]; pgf = US[(size_t)(jj) * USL + (dir * 2 + 1) * 4 + head]; } while (0)
    ML_LOAD(j);
    for (int step = 0; step < RB; ++step) {
        if (tid < 256) { qs[tid] = pq; ks[tid] = pk; } else if (tid < 320) vs[tid - 256] = pv;
        const float gi = pgi + gbi, lf = logsigmoid_f(pgf + gbf);
        const int jcur = j;
        if (step + 1 < RB) { j = scan_row(step + 1, dir); ML_LOAD(j); }
        const float mn = fmaxf(lf + m, gi), fs = expf(lf + m - mn), is = expf(gi - mn); m = mn;
        __syncthreads();
        const float vv = vs[e] * is; float p = 0.f;
#pragma unroll
        for (int i = 0; i < 32; ++i) { const int d = dg * 32 + i; C[i] = fs * C[i] + ks[d] * vv; p += qs[d] * C[i]; }
        part[dg * 64 + e] = p;
        if (tid < 256) { nn = fs * nn + is * ks[tid]; const float t = wave_sum(qs[tid] * nn); if (lane == 0) qnp[dg] = t; }
        __syncthreads();
        if (tid < 64) { float num = 0.f;
#pragma unroll
            for (int g = 0; g < 8; ++g) num += part[g * 64 + tid];
            const float qn = (qnp[0] + qnp[1]) + (qnp[2] + qnp[3]); const float den = fmaxf(fabsf(qn), expf(-m));
            H[(size_t)jcur * 1024 + head * 256 + es * 64 + tid] = num / den; }
    }
#undef ML_LOAD
}
__device__ __forceinline__ void ssd_simple_unit(KArgs& a, int l, int unit, LAS unsigned char* ldsb, int tid) {
    const int head = unit & 15, dir = (unit >> 4) & 1, bl = unit >> 5, grp = head >> 3;
    const int lane = tid & 63, ng = tid >> 6, p = lane;
    LAS float* xs = (LAS float*)ldsb; LAS float* Bs = xs + 64; LAS float* Cs = Bs + 128; LAS float* part = Cs + 128;
    const bf16* U = (const bf16*)(a.ws + WS_U) + (size_t)bl * RB * NU;
    const float* US = (const float*)(a.ws + WS_US) + (size_t)bl * RB * USL;
    float* Yo = (float*)(a.ws + WS_SC) + (size_t)(2 + dir) * RP * 1024 + (size_t)bl * RB * 1024;
    const float dtb = a.in[15][l * 32 + dir * 16 + head], av = -expf(a.in[16][l * 32 + dir * 16 + head]);
    int ch = -1;
    if (tid < 64) ch = head * 64 + tid; else if (tid < 192) ch = 1024 + grp * 128 + (tid - 64); else if (tid < 320) ch = 1280 + grp * 128 + (tid - 192);
    float cw[5], cb = 0.f;
#pragma unroll
    for (int tp = 0; tp < 5; ++tp) cw[tp] = (ch >= 0) ? a.in[13][(size_t)(l * 5 + tp) * 1536 + ch] : 0.f;
    if (ch >= 0) cb = a.in[14][l * 1536 + ch];
    float h[16];
#pragma unroll
    for (int i = 0; i < 16; ++i) h[i] = 0.f;
    float pre[5], pdt = 0.f;
#pragma unroll
    for (int tp = 0; tp < 5; ++tp) pre[tp] = 0.f;
    int j = scan_row(0, dir);
#define SSD_LOAD(jj) do { const int lo_ = ((jj) < CTXL) ? 0 : CTXL, hi_ = ((jj) < CTXL) ? CTXL : RB; \
        if (ch >= 0) { _Pragma("unroll") for (int tp = 0; tp < 5; ++tp) { const int jn = (jj) + tp - 2; pre[tp] = (jn >= lo_ && jn < hi_) ? bf2f(U[(size_t)jn * NU + UXBC + ch]) : 0.f; } } \
        pdt = US[(size_t)(jj) * USL + 16 + dir * 16 + head]; } while (0)
    SSD_LOAD(j);
    for (int step = 0; step < RB; ++step) {
        if (ch >= 0) { float s = cb;
#pragma unroll
            for (int tp = 0; tp < 5; ++tp) s += cw[tp] * pre[tp];
            s = silu_f(s);
            if (tid < 64) xs[tid] = s; else if (tid < 192) Bs[tid - 64] = s; else Cs[tid - 192] = s; }
        const float dt = softplus_f(pdt + dtb), dA = expf(dt * av);
        const int jcur = j;
        if (step + 1 < RB) { j = scan_row(step + 1, dir); SSD_LOAD(j); }
        __syncthreads();
        const float xv = xs[p] * dt; float yp = 0.f;
#pragma unroll
        for (int i = 0; i < 16; ++i) { const int n = ng * 16 + i; h[i] = dA * h[i] + Bs[n] * xv; yp += Cs[n] * h[i]; }
        part[ng * 64 + p] = yp;
        __syncthreads();
        if (tid < 64) { float y = 0.f;
#pragma unroll
            for (int g = 0; g < 8; ++g) y += part[g * 64 + tid];
            Yo[(size_t)jcur * 1024 + head * 64 + tid] = y; }
    }
#undef SSD_LOAD
}
__device__ __forceinline__ void rot4(float (&q)[8], const f32x4 c4, const f32x4 s4) {
    float t;
    t = q[0] * c4.x - q[1] * s4.x; q[1] = q[0] * s4.x + q[1] * c4.x; q[0] = t;
    t = q[2] * c4.y - q[3] * s4.y; q[3] = q[2] * s4.y + q[3] * c4.y; q[2] = t;
    t = q[4] * c4.z - q[5] * s4.z; q[5] = q[4] * s4.z + q[5] * c4.z; q[4] = t;
    t = q[6] * c4.w - q[7] * s4.w; q[7] = q[6] * s4.w + q[7] * c4.w; q[6] = t;
}
__device__ __forceinline__ void unpack8(const v4u w, float (&q)[8]) { q[0] = bflo(w.x); q[1] = bfhi(w.x); q[2] = bflo(w.y); q[3] = bfhi(w.y); q[4] = bflo(w.z); q[5] = bfhi(w.z); q[6] = bflo(w.w); q[7] = bfhi(w.w); }
__device__ __forceinline__ void attn_simple_task(KArgs& a, int l, int bl, int j, int g, LAS float* qs, LAS float* ps, int lane) {
    const bf16* Ub = (const bf16*)(a.ws + WS_U) + (size_t)bl * RB * NU;
    const bf16* urow = Ub + (size_t)j * NU;
    const float* rc = (const float*)(a.ws + WS_ROPE); const float* rs = rc + 2048 * 64;
    const bool is_main = j >= CTXL; const int t = j - CTXL;
    {
        float q[8]; unpack8(*(const v4u*)(urow + UQ + g * 512 + lane * 8), q);
        if (is_main) { const int p0 = ((lane * 8) & 127) >> 1; rot4(q, *(const f32x4*)(rc + t * 64 + p0), *(const f32x4*)(rs + t * 64 + p0)); }
#pragma unroll
        for (int i = 0; i < 8; ++i) qs[lane * 8 + i] = q[i] * 0.08838834764831845f;
    }
    LDS_WAIT(); asm volatile("" ::: "memory");
    const int nloc = is_main ? 257 : 0, nk = nloc + CTXL;
    float s[9][4];
#pragma unroll
    for (int i = 0; i < 9; ++i) {
        const int kk = lane + 64 * i;
        bool valid = kk < nk, rope = false; int krow = 0;
        if (kk < nloc) { const int pos = t - 128 + kk; valid = (pos >= 0 && pos < SEQ); krow = CTXL + pos; rope = true; } else krow = kk - nloc;
        float d0 = 0.f, d1 = 0.f, d2 = 0.f, d3 = 0.f;
        if (valid) {
            const bf16* kr = Ub + (size_t)krow * NU + UK + g * 128; const int pos = krow - CTXL;
            for (int ch = 0; ch < 16; ++ch) {
                float k[8]; unpack8(*(const v4u*)(kr + ch * 8), k);
                if (rope) rot4(k, *(const f32x4*)(rc + pos * 64 + ch * 4), *(const f32x4*)(rs + pos * 64 + ch * 4));
#pragma unroll
                for (int i2 = 0; i2 < 8; ++i2) { const float kv = k[i2]; d0 += kv * qs[ch * 8 + i2]; d1 += kv * qs[128 + ch * 8 + i2]; d2 += kv * qs[256 + ch * 8 + i2]; d3 += kv * qs[384 + ch * 8 + i2]; }
            }
        }
        s[i][0] = valid ? d0 : -INFINITY; s[i][1] = valid ? d1 : -INFINITY; s[i][2] = valid ? d2 : -INFINITY; s[i][3] = valid ? d3 : -INFINITY;
    }
    float inv[4];
#pragma unroll
    for (int h = 0; h < 4; ++h) {
        const float sink = a.in[10][l * 8 + g * 4 + h]; float mx = sink;
#pragma unroll
        for (int i = 0; i < 9; ++i) mx = fmaxf(mx, s[i][h]);
        mx = wave_max(mx); float sum = 0.f;
#pragma unroll
        for (int i = 0; i < 9; ++i) { const float pv = expf(s[i][h] - mx); s[i][h] = pv; sum += pv; }
        sum = wave_sum(sum) + expf(sink - mx); inv[h] = 1.0f / sum;
    }
#pragma unroll
    for (int i = 0; i < 9; ++i) *(LAS f32x4*)(ps + (lane + 64 * i) * 4) = (f32x4){s[i][0], s[i][1], s[i][2], s[i][3]};
    LDS_WAIT(); asm volatile("" ::: "memory");
    float o[4][2];
#pragma unroll
    for (int h = 0; h < 4; ++h) { o[h][0] = 0.f; o[h][1] = 0.f; }
    for (int kk = 0; kk < nk; ++kk) {
        int krow;
        if (kk < nloc) { const int pos = t - 128 + kk; if (pos < 0 || pos >= SEQ) continue; krow = CTXL + pos; } else krow = kk - nloc;
        const unsigned w = *(const unsigned*)(Ub + (size_t)krow * NU + UV + g * 128 + 2 * lane); const float v0 = bflo(w), v1 = bfhi(w);
        const f32x4 pp = *(const LAS f32x4*)(ps + kk * 4);
        o[0][0] += pp.x * v0; o[0][1] += pp.x * v1; o[1][0] += pp.y * v0; o[1][1] += pp.y * v1; o[2][0] += pp.z * v0; o[2][1] += pp.z * v1; o[3][0] += pp.w * v0; o[3][1] += pp.w * v1;
    }
    bf16* orow = (bf16*)(a.ws + WS_OBR) + (size_t)(bl * RB + j) * LDK3;
#pragma unroll
    for (int h = 0; h < 4; ++h) { const int head = g * 4 + h; const unsigned zw = *(const unsigned*)(urow + UAZ + head * 128 + 2 * lane);
        *(unsigned*)(orow + head * 128 + 2 * lane) = pk2(o[h][0] * inv[h] * silu_f(bflo(zw)), o[h][1] * inv[h] * silu_f(bfhi(zw))); }
    LDS_WAIT(); asm volatile("" ::: "memory");
}
typedef __attribute__((address_space(3))) unsigned char lds_u8;
__device__ __forceinline__ bf16x8 ldfrag(const lds_u8* base, int row, int ld_bytes, int kbyte) { return *(const LAS bf16x8*)(base + row * ld_bytes + kbyte); }
#define MFMA16(a_, b_, c_) __builtin_amdgcn_mfma_f32_16x16x32_bf16((a_), (b_), (c_), 0, 0, 0)
__device__ __forceinline__ unsigned lds_addr(const lds_u8* p) { return (unsigned)(size_t)p; }
__device__ __forceinline__ unsigned tr_lane(int lane, int RS) { return (unsigned)(((lane & 15) >> 2) * RS + (lane & 3) * 8); }
typedef short v4s_t __attribute__((ext_vector_type(4)));
__device__ __forceinline__ bf16x8 tr_frag(unsigned a0, unsigned a1) {
    const v4s_t lo = __builtin_amdgcn_ds_read_tr16_b64_v4i16((LAS v4s_t*)a0), hi = __builtin_amdgcn_ds_read_tr16_b64_v4i16((LAS v4s_t*)a1);
    return (bf16x8){lo[0], lo[1], lo[2], lo[3], hi[0], hi[1], hi[2], hi[3]};
}
template <int STEP, int HI> __device__ __forceinline__ void tr_frags2(unsigned base, bf16x8 (&f)[2]) { f[0] = tr_frag(base, base + HI); f[1] = tr_frag(base + STEP, base + STEP + HI); }
template <int STEP, int HI> __device__ __forceinline__ void tr_frags4(unsigned base, bf16x8 (&f)[4]) {
#pragma unroll
    for (int i = 0; i < 4; ++i) f[i] = tr_frag(base + i * STEP, base + i * STEP + HI); }
template <int STEP, int HI> __device__ __forceinline__ void tr_frags5(unsigned base, bf16x8 (&f)[5]) {
#pragma unroll
    for (int i = 0; i < 5; ++i) f[i] = tr_frag(base + i * STEP, base + i * STEP + HI); }
__device__ __forceinline__ bf16x8 scale_frag(bf16x8 f, f32x4 w0, f32x4 w1) {
    const v4u u = __builtin_bit_cast(v4u, f); v4u w;
    w.x = pk2(bflo(u.x) * w0[0], bfhi(u.x) * w0[1]); w.y = pk2(bflo(u.y) * w0[2], bfhi(u.y) * w0[3]); w.z = pk2(bflo(u.z) * w1[0], bfhi(u.z) * w1[1]); w.w = pk2(bflo(u.w) * w1[2], bfhi(u.w) * w1[3]);
    return __builtin_bit_cast(bf16x8, w);
}

__device__ __forceinline__ int chunk_r0(int c, int dir) { return dir == 0 ? 64 * c : (c < 4 ? 192 - 64 * c : 2240 - 64 * (c - 4)); }
__device__ __forceinline__ void mlsc_unit(KArgs& a, int l, int unit, LAS unsigned char* lds, int tid) {
    const int dir = unit & 1, head = (unit >> 1) & 3, bl = unit >> 3, lane = tid & 63, wid = __builtin_amdgcn_readfirstlane(tid >> 6);
    const float* US = (const float*)(a.ws + WS_US) + (size_t)bl * RB * USL;
    const float gbi = a.in[11][l * 16 + (dir * 2) * 4 + head], gbf = a.in[11][l * 16 + (dir * 2 + 1) * 4 + head];
    LAS float* cs = (LAS float*)lds;
    float av[5], bb[5], cmv[5];
#pragma unroll
    for (int k = 0; k < 5; ++k) { const int c = wid + 8 * k; av[k] = 0.f; bb[k] = 0.f; cmv[k] = 0.f;
        if (c < 36) { const size_t r = (size_t)scan_row(64 * c + lane, dir) * USL; const float gi = US[r + (dir * 2) * 4 + head] + gbi, lf = logsigmoid_f(US[r + (dir * 2 + 1) * 4 + head] + gbf);
            float b = lf;
#pragma unroll
            for (int o = 1; o < 64; o <<= 1) { const float t = shup(b, o); if (lane >= o) b += t; }
            const float a_ = gi - b; float cm = a_;
#pragma unroll
            for (int o = 1; o < 64; o <<= 1) { const float t = shup(cm, o); if (lane >= o) cm = fmaxf(cm, t); }
            av[k] = a_; bb[k] = b; cmv[k] = cm; if (lane == 63) { cs[c] = cm; cs[64 + c] = b; } } }
    __syncthreads();
    if (tid == 0) { float m = 0.f; for (int c = 0; c < 36; ++c) { cs[128 + c] = m; m = cs[64 + c] + fmaxf(m, cs[c]); } }
    __syncthreads();
    float* MS = (float*)(a.ws + WS_MSC) + (size_t)unit * 36 * 384;
#pragma unroll
    for (int k = 0; k < 5; ++k) { const int c = wid + 8 * k;
        if (c < 36) { const float mp = cs[128 + c], Mt = fmaxf(mp, cmv[k]), M63 = fmaxf(mp, cs[c]); float* rec = MS + (size_t)c * 384;
            rec[lane] = av[k] * L2E; rec[64 + lane] = Mt * L2E; rec[128 + lane] = expf(mp - Mt); rec[192 + lane] = expf(-(bb[k] + Mt)); rec[256 + lane] = expf(av[k] - M63) * 0.0625f;
            if (lane == 0) rec[320] = expf(mp - M63); } }
    __syncthreads();
}
__device__ __forceinline__ void sdsc_task(KArgs& a, int l, int T, int lane) {
    const int head = T & 15, c = (T >> 4) % 36, rest = T / (16 * 36), dir = rest & 1, bl = rest >> 1;
    const float* US = (const float*)(a.ws + WS_US) + (size_t)bl * RB * USL;
    const float dtb = a.in[15][l * 32 + dir * 16 + head], av = -expf(a.in[16][l * 32 + dir * 16 + head]);
    const int R0 = chunk_r0(c, dir), row = dir ? (R0 + 63 - lane) : (R0 + lane);
    const float dt = softplus_f(US[(size_t)row * USL + 16 + dir * 16 + head] + dtb); float cum = dt * av;
#pragma unroll
    for (int o = 1; o < 64; o <<= 1) { const float t = shup(cum, o); if (lane >= o) cum += t; }
    const float c63 = shidx(cum, 63);
    float* rec = (float*)(a.ws + WS_SSC) + ((size_t)((bl * 2 + dir) * 36 + c) * 16 + head) * 320;
    rec[lane] = dt; rec[64 + lane] = cum * L2E; rec[128 + lane] = expf(cum); rec[192 + lane] = expf(c63 - cum) * dt; if (lane == 0) rec[256] = expf(c63);
}

constexpr int ML_LD = 528, ML_VLD = 144, ML_WLD = 176;
constexpr int MLO_Q = 0, MLO_K = 33792, MLO_V = 67584, MLO_S = 78848, MLO_CT = 88064, MLO_SC = 130304, MLO_END = 132096;
static_assert(MLO_END <= MISC_OFF, "mLSTM LDS map");
__device__ __forceinline__ void mlstm_chunk_unit(KArgs& a, int l, int unit, LAS unsigned char* lds, int tid_in) {
    const int es = unit & 3, dir = (unit >> 2) & 1, head = (unit >> 3) & 3, bl = unit >> 5;
    const int wid = __builtin_amdgcn_readfirstlane(tid_in >> 6);
    const bf16* U = (const bf16*)(a.ws + WS_U) + (size_t)bl * RB * NU;
    const float* MS = (const float*)(a.ws + WS_MSC) + (size_t)(bl * 8 + head * 2 + dir) * 36 * 384;
    bf16* H = (bf16*)(a.ws + WS_SC) + (size_t)dir * RP * 1024 + (size_t)bl * RB * 1024 + head * 256 + es * 64;
    const lds_u8* Qs = lds + MLO_Q; const lds_u8* Ks = lds + MLO_K; const lds_u8* Vs = lds + MLO_V; const lds_u8* Ss = lds + MLO_S; const lds_u8* CTs = lds + MLO_CT;
    LAS float* sc = (LAS float*)(lds + MLO_SC);
    for (int i = tid_in; i < (MLO_SC - MLO_CT) / 4; i += 512) ((LAS unsigned*)(lds + MLO_CT))[i] = 0u;
    for (int i = tid_in; i < 64 * 24; i += 512) { const int r = i / 24, c = 64 + i % 24; ((LAS bf16*)(lds + MLO_V))[r * 88 + c] = (c == 64) ? (bf16)0x3F80 : (bf16)0; }
    f32x4 st[2][5];
#pragma unroll
    for (int i = 0; i < 2; ++i)
#pragma unroll
        for (int j = 0; j < 5; ++j) st[i][j] = (f32x4){0.f, 0.f, 0.f, 0.f};
    v4u pq[4], pk[4], pv; f32x4 psc = (f32x4){0.f, 0.f, 0.f, 0.f};
#define MLC_LOAD(cc, tid) do { \
        _Pragma("unroll") for (int i = 0; i < 4; ++i) { const int ch = (tid) + 512 * i, s = ch >> 5, c16 = ch & 31; const bf16* ur = U + (size_t)scan_row(64 * (cc) + s, dir) * NU + head * 256 + c16 * 8; \
            pq[i] = *(const v4u*)(ur + UMQ); pk[i] = *(const v4u*)(ur + UMK); } \
        { const int s = (tid) >> 3, c8 = (tid) & 7; pv = *(const v4u*)(U + (size_t)scan_row(64 * (cc) + s, dir) * NU + UMV + head * 256 + es * 64 + c8 * 8); } \
        { const float* rec = MS + (size_t)(cc) * 384; if ((tid) < 81) psc = *(const f32x4*)(rec + 4 * (tid)); } } while (0)
    MLC_LOAD(0, tid_in);
    __syncthreads();
    for (int c = 0; c < RB / 64; ++c) {
        int tid = tid_in; asm volatile("" : "+v"(tid));
        const int lane = tid & 63, fr = lane & 15, fq = lane >> 4;
#pragma unroll
        for (int i = 0; i < 4; ++i) { const int ch = tid + 512 * i, s = ch >> 5, c16 = ch & 31; *(LAS v4u*)(lds + MLO_Q + s * ML_LD + c16 * 16) = pq[i]; *(LAS v4u*)(lds + MLO_K + s * ML_LD + c16 * 16) = pk[i]; }
        if (tid < 81) *(LAS f32x4*)(sc + 4 * tid) = psc;
        if (c > 0) {
#pragma unroll
            for (int dt = 0; dt < 2; ++dt)
#pragma unroll
                for (int te = 0; te < 5; ++te) { v2u o; o.x = pk2(st[dt][te][0], st[dt][te][1]); o.y = pk2(st[dt][te][2], st[dt][te][3]);
                    *(LAS v2u*)(lds + MLO_CT + (te * 16 + fr) * ML_LD + ((2 * wid + dt) * 16 + fq * 4) * 2) = o; }
        }
        {
            const int s = tid >> 3, c8 = tid & 7; *(LAS v4u*)(lds + MLO_V + s * ML_WLD + c8 * 16) = pv;
        }
        if (c + 1 < RB / 64) MLC_LOAD(c + 1, tid);
        __syncthreads();
        for (int rp1 = 0; rp1 < ((MK_DUP == 20) ? 2 : 1); ++rp1) {
            const int tm = wid >> 1, tn0 = (wid & 1) * 2;
            f32x4 sa0 = (f32x4){0.f, 0.f, 0.f, 0.f}, sa1 = sa0;
#pragma unroll
            for (int ks = 0; ks < 8; ++ks) { const bf16x8 qf = ldfrag(Qs, tm * 16 + fr, ML_LD, ks * 64 + fq * 16);
                sa0 = MFMA16(ldfrag(Ks, tn0 * 16 + fr, ML_LD, ks * 64 + fq * 16), qf, sa0); sa1 = MFMA16(ldfrag(Ks, (tn0 + 1) * 16 + fr, ML_LD, ks * 64 + fq * 16), qf, sa1); }
            const int t = tm * 16 + fr; const float Mtt = sc[64 + t];
#pragma unroll
            for (int j = 0; j < 2; ++j) { const int s0 = (tn0 + j) * 16 + fq * 4; const f32x4 av4 = *(const LAS f32x4*)(sc + s0); const f32x4 sv = j ? sa1 : sa0;
                float w[4];
#pragma unroll
                for (int r = 0; r < 4; ++r) w[r] = (s0 + r <= t) ? sv[r] * 0.0625f * ex2(av4[r] - Mtt) : 0.f;
                v2u o; o.x = pk2(w[0], w[1]); o.y = pk2(w[2], w[3]); *(LAS v2u*)(lds + MLO_S + t * ML_VLD + s0 * 2) = o; }
        }
        __syncthreads();
        for (int rp2 = 0; rp2 < ((MK_DUP == 21) ? 2 : 1); ++rp2) {
            const int tm = wid & 3, te0 = (wid < 4) ? 0 : 2;
            f32x4 a1[3], a2[3];
#pragma unroll
            for (int i = 0; i < 3; ++i) { a1[i] = (f32x4){0.f, 0.f, 0.f, 0.f}; a2[i] = a1[i]; }
#pragma unroll
            for (int ks = 0; ks < 8; ++ks) { const bf16x8 qf = ldfrag(Qs, tm * 16 + fr, ML_LD, ks * 64 + fq * 16);
#pragma unroll
                for (int i = 0; i < 3; ++i) a1[i] = MFMA16(ldfrag(CTs, ((i < 2) ? te0 + i : 4) * 16 + fr, ML_LD, ks * 64 + fq * 16), qf, a1[i]); }
#pragma unroll
            for (int ks = 0; ks < 2; ++ks) { const bf16x8 sf = ldfrag(Ss, tm * 16 + fr, ML_VLD, ks * 64 + fq * 16);
                const unsigned vb = lds_addr(Vs) + (ks * 32 + 8 * fq) * ML_WLD + tr_lane(lane, ML_WLD);
                bf16x8 vf2[2]; tr_frags2<32, 4 * ML_WLD>(vb + te0 * 32, vf2); const bf16x8 vf4 = tr_frag(vb + 4 * 32, vb + 4 * 32 + 4 * ML_WLD);
                a2[0] = MFMA16(vf2[0], sf, a2[0]); a2[1] = MFMA16(vf2[1], sf, a2[1]); a2[2] = MFMA16(vf4, sf, a2[2]); }
            const int t = tm * 16 + fr; const float ei = sc[128 + t];
#pragma unroll
            for (int i = 0; i < 3; ++i) a1[i] = a1[i] * ei + a2[i];
            const float den = shidx(a1[2][0], fr);
            const float inv = 1.0f / fmaxf(fabsf(den), sc[192 + t]);
            bf16* hrow = H + (size_t)scan_row(64 * c + t, dir) * 1024;
#pragma unroll
            for (int i = 0; i < 2; ++i) { const f32x4 hv = a1[i] * inv; v2u w; w.x = pk2(hv[0], hv[1]); w.y = pk2(hv[2], hv[3]); *(v2u*)(hrow + (te0 + i) * 16 + fq * 4) = w; }
        }
        {
            const float sp = sc[320];
#pragma unroll
            for (int i = 0; i < 2; ++i)
#pragma unroll
                for (int j = 0; j < 5; ++j) st[i][j] *= sp;
#pragma unroll
            for (int ks = 0; ks < 2; ++ks) {
                bf16x8 kf[2];
                const f32x4 wd0 = *(const LAS f32x4*)(sc + 256 + ks * 32 + fq * 8), wd1 = *(const LAS f32x4*)(sc + 256 + ks * 32 + fq * 8 + 4);
                { const unsigned ka = lds_addr(Ks) + (ks * 32 + 8 * fq) * ML_LD + (2 * wid) * 32 + tr_lane(lane, ML_LD); tr_frags2<32, 4 * ML_LD>(ka, kf); kf[0] = scale_frag(kf[0], wd0, wd1); kf[1] = scale_frag(kf[1], wd0, wd1); }
                const unsigned vb = lds_addr(Vs) + (ks * 32 + 8 * fq) * ML_WLD + tr_lane(lane, ML_WLD);
                bf16x8 vfa[5]; tr_frags5<32, 4 * ML_WLD>(vb, vfa);
#pragma unroll
                for (int te = 0; te < 5; ++te) { const bf16x8 vf = vfa[te];
                    st[0][te] = MFMA16(kf[0], vf, st[0][te]); st[1][te] = MFMA16(kf[1], vf, st[1][te]); }
            }
        }
        __syncthreads();
    }
#undef MLC_LOAD
}

__device__ __forceinline__ void rope_unit(KArgs& a, int unit, int tid) {
    const int bl = unit >> 6, t0 = (unit & 63) * 32;
    const bf16* Ub = (const bf16*)(a.ws + WS_U) + (size_t)(bl * RB + CTXL + t0) * NU; bf16* Qb = (bf16*)(a.ws + WS_QK) + (size_t)(bl * RB + CTXL + t0) * 1280;
    const float* rc = (const float*)(a.ws + WS_ROPE); const float* rs = rc + 2048 * 64;
    for (int i0 = tid; i0 < 32 * 160; i0 += 512 * 5) {
        v4u in[5]; f32x4 cs[5], sn[5];
#pragma unroll
        for (int j = 0; j < 5; ++j) { const int i = i0 + 512 * j, r = i / 160, pc = i % 160; in[j] = *(const v4u*)(Ub + (size_t)r * NU + pc * 8);
            const int p0 = (t0 + r) * 64 + ((pc * 8) & 127) / 2; cs[j] = *(const f32x4*)(rc + p0); sn[j] = *(const f32x4*)(rs + p0); }
#pragma unroll
        for (int j = 0; j < 5; ++j) { const int i = i0 + 512 * j, r = i / 160, pc = i % 160;
            float q[8]; unpack8(in[j], q); rot4(q, cs[j], sn[j]);
            v4u w; w.x = pk2(q[0], q[1]); w.y = pk2(q[2], q[3]); w.z = pk2(q[4], q[5]); w.w = pk2(q[6], q[7]); *(v4u*)(Qb + (size_t)r * 1280 + pc * 8) = w; } }
}

__device__ __forceinline__ void conv_unit(KArgs& a, int l, int unit, int tid) {
    const int rb0 = unit * 32, j0 = rb0 % RB, lo = rb0 - j0 + ((j0 < CTXL) ? 0 : CTXL), hi = rb0 - j0 + ((j0 < CTXL) ? CTXL : RB);
    const bf16* U = (const bf16*)(a.ws + WS_U); bf16* XC = (bf16*)(a.ws + WS_XC);
    for (int t = tid; t < 768; t += 512) {
        const int cg = t % 192, r0 = rb0 + (t / 192) * 8, ch = cg * 8;
        v4u pre[12];
#pragma unroll
        for (int i = 0; i < 12; ++i) { const int row = r0 - 2 + i; const int rc = row < lo ? lo : (row >= hi ? hi - 1 : row); const v4u w = *(const v4u*)(U + (size_t)rc * NU + UXBC + ch); pre[i] = (rc == row) ? w : (v4u){0u, 0u, 0u, 0u}; }
        f32x4 cw[5][2], cb[2];
#pragma unroll
        for (int tp = 0; tp < 5; ++tp) { cw[tp][0] = *(const f32x4*)(a.in[13] + (size_t)(l * 5 + tp) * 1536 + ch); cw[tp][1] = *(const f32x4*)(a.in[13] + (size_t)(l * 5 + tp) * 1536 + ch + 4); }
        cb[0] = *(const f32x4*)(a.in[14] + l * 1536 + ch); cb[1] = *(const f32x4*)(a.in[14] + l * 1536 + ch + 4);
#pragma unroll
        for (int i = 0; i < 8; ++i) { f32x4 s0 = cb[0], s1 = cb[1];
#pragma unroll
            for (int tp = 0; tp < 5; ++tp) { const v4u w = pre[i + tp];
                s0 += cw[tp][0] * (f32x4){bflo(w.x), bfhi(w.x), bflo(w.y), bfhi(w.y)}; s1 += cw[tp][1] * (f32x4){bflo(w.z), bfhi(w.z), bflo(w.w), bfhi(w.w)}; }
            v4u o; o.x = pk2(s0[0] * fsig(s0[0]), s0[1] * fsig(s0[1])); o.y = pk2(s0[2] * fsig(s0[2]), s0[3] * fsig(s0[3])); o.z = pk2(s1[0] * fsig(s1[0]), s1[1] * fsig(s1[1])); o.w = pk2(s1[2] * fsig(s1[2]), s1[3] * fsig(s1[3]));
            *(v4u*)(XC + (size_t)(r0 + i) * 1536 + ch) = o; }
    }
}

constexpr int SD_CLD = 272, SD_XLD = 144, SD_WLD = 528;
constexpr int SDO_C = 0, SDO_B = 17408, SDO_X = 34816, SDO_MX = 68608, SDO_SC = 105472, SDO_END = 110592;
template <int DIR> __device__ __forceinline__ void ssd_chunk_unit_d(KArgs& a, int l, int unit, LAS unsigned char* lds, int tid) {
    constexpr int dir = DIR; const int hq = unit & 1, g = (unit >> 1) & 1, bl = unit >> 3;
    const int lane = tid & 63, wid = __builtin_amdgcn_readfirstlane(tid >> 6), fr = lane & 15, fq = lane >> 4;
    const int hl = wid >> 1, half = wid & 1, head = g * 8 + hq * 4 + hl;
    const bf16* XC = (const bf16*)(a.ws + WS_XC) + (size_t)bl * RB * 1536;
    const float* SS = (const float*)(a.ws + WS_SSC) + ((size_t)(bl * 2 + dir) * 36 * 16 + g * 8 + hq * 4) * 320;
    bf16* Yo = (bf16*)(a.ws + WS_SC) + (size_t)(2 + dir) * RP * 1024 + (size_t)bl * RB * 1024 + head * 64;
    const lds_u8* Cs = lds + SDO_C; const lds_u8* Bs = lds + SDO_B; const lds_u8* Xs = lds + SDO_X; const lds_u8* MXs = lds + SDO_MX + hl * 9216;
    LAS float* scw = (LAS float*)(lds + SDO_SC) + hl * 320;
    f32x4 st[8][2];
#pragma unroll
    for (int i = 0; i < 8; ++i) { st[i][0] = (f32x4){0.f, 0.f, 0.f, 0.f}; st[i][1] = st[i][0]; }
    v4u px[4], pb[2], pc[2]; f32x4 psc = (f32x4){0.f, 0.f, 0.f, 0.f};
#define SDC_LOAD(cc) do { const int R0_ = chunk_r0((cc), dir); \
        _Pragma("unroll") for (int i = 0; i < 4; ++i) { const int id = tid + 512 * i; px[i] = *(const v4u*)(XC + (size_t)(R0_ + (id >> 5)) * 1536 + (g * 8 + hq * 4) * 64 + (id & 31) * 8); } \
        _Pragma("unroll") for (int i = 0; i < 2; ++i) { const int id = tid + 512 * i; const bf16* xr = XC + (size_t)(R0_ + (id >> 4)) * 1536 + g * 128 + (id & 15) * 8; pb[i] = *(const v4u*)(xr + 1024); pc[i] = *(const v4u*)(xr + 1280); } \
        { const float* rec = SS + (size_t)(cc) * 16 * 320; if (tid < 320) psc = *(const f32x4*)(rec + 4 * tid); } } while (0)
    SDC_LOAD(0);
    const int tid_outer = tid;
    for (int c = 0; c < RB / 64; ++c) {
        const int R0 = chunk_r0(c, dir);
        int tid = tid_outer; asm volatile("" : "+v"(tid));
        const int lane = tid & 63, fr = lane & 15, fq = lane >> 4;
        if (tid < 320) *(LAS f32x4*)(lds + SDO_SC + tid * 16) = psc;
#pragma unroll
        for (int i = 0; i < 2; ++i) { const int id = tid + 512 * i, rr = id >> 4, s = dir ? 63 - rr : rr; *(LAS v4u*)(lds + SDO_B + s * SD_CLD + (id & 15) * 16) = pb[i]; *(LAS v4u*)(lds + SDO_C + s * SD_CLD + (id & 15) * 16) = pc[i]; }
#pragma unroll
        for (int i = 0; i < 4; ++i) { const int id = tid + 512 * i, rr = id >> 5, s = dir ? 63 - rr : rr; *(LAS v4u*)(lds + SDO_X + s * SD_WLD + (id & 31) * 16) = px[i]; }
        if (c + 1 < RB / 64) SDC_LOAD(c + 1);
        __syncthreads();
        {
#pragma unroll
            for (int ti = 0; ti < 2; ++ti) { const int tt = 2 * half + ti;
                f32x4 cbacc[4];
#pragma unroll
                for (int si = 0; si < 4; ++si) cbacc[si] = (f32x4){0.f, 0.f, 0.f, 0.f};
#pragma unroll
                for (int ks = 0; ks < 4; ++ks) { const bf16x8 cf = ldfrag(Cs, tt * 16 + fr, SD_CLD, ks * 64 + fq * 16);
#pragma unroll
                    for (int si = 0; si < 4; ++si) cbacc[si] = MFMA16(ldfrag(Bs, si * 16 + fr, SD_CLD, ks * 64 + fq * 16), cf, cbacc[si]); }
                const int t = tt * 16 + fr; const float cumt = scw[64 + t];
#pragma unroll
                for (int si = 0; si < 4; ++si) { const int s0 = si * 16 + fq * 4; const f32x4 c4 = *(const LAS f32x4*)(scw + 64 + s0), d4 = *(const LAS f32x4*)(scw + s0);
                    float w[4];
#pragma unroll
                    for (int r = 0; r < 4; ++r) w[r] = (s0 + r <= t) ? cbacc[si][r] * d4[r] * ex2(cumt - c4[r]) : 0.f;
                    v2u o; o.x = pk2(w[0], w[1]); o.y = pk2(w[2], w[3]); *(LAS v2u*)(lds + SDO_MX + hl * 9216 + t * SD_XLD + s0 * 2) = o; } }
        }
        __syncthreads();
        {
            f32x4 acc[4][2];
#pragma unroll
            for (int i = 0; i < 4; ++i) { acc[i][0] = (f32x4){0.f, 0.f, 0.f, 0.f}; acc[i][1] = acc[i][0]; }
#pragma unroll
            for (int ks = 0; ks < 4; ++ks) {
                bf16x8 hb[2];
#pragma unroll
                for (int pt = 0; pt < 2; ++pt) { const f32x4 s0 = st[2 * ks][pt], s1 = st[2 * ks + 1][pt];
                    v4u w; w.x = pk2(s0[0], s0[1]); w.y = pk2(s0[2], s0[3]); w.z = pk2(s1[0], s1[1]); w.w = pk2(s1[2], s1[3]); hb[pt] = __builtin_bit_cast(bf16x8, w); }
#pragma unroll
                for (int tt = 0; tt < 4; ++tt) { const lds_u8* cr = Cs + (tt * 16 + fr) * SD_CLD + (ks * 32 + 4 * fq) * 2;
                    const v2u c0 = *(const LAS v2u*)cr, c1 = *(const LAS v2u*)(cr + 32);
                    v4u cw; cw.x = c0.x; cw.y = c0.y; cw.z = c1.x; cw.w = c1.y; const bf16x8 cf = __builtin_bit_cast(bf16x8, cw);
                    acc[tt][0] = MFMA16(hb[0], cf, acc[tt][0]); acc[tt][1] = MFMA16(hb[1], cf, acc[tt][1]); }
            }
#pragma unroll
            for (int tt = 0; tt < 4; ++tt) { const float e1 = scw[128 + tt * 16 + fr]; acc[tt][0] *= e1; acc[tt][1] *= e1; }
            const float dA = scw[256];
#pragma unroll
            for (int i = 0; i < 8; ++i) { st[i][0] *= dA; st[i][1] *= dA; }
#pragma unroll
            for (int ks = 0; ks < 2; ++ks) {
                const unsigned xb = lds_addr(Xs) + (ks * 32 + 8 * fq) * SD_WLD + (hl * 64 + (2 * half) * 16) * 2 + tr_lane(lane, SD_WLD);
                bf16x8 xfa[2]; tr_frags2<32, 4 * SD_WLD>(xb, xfa); const bf16x8 xf0 = xfa[0], xf1 = xfa[1];
#pragma unroll
                for (int tt = 0; tt < 4; ++tt) { const bf16x8 mf = ldfrag(MXs, tt * 16 + fr, SD_XLD, ks * 64 + fq * 16); acc[tt][0] = MFMA16(xf0, mf, acc[tt][0]); acc[tt][1] = MFMA16(xf1, mf, acc[tt][1]); }
                const f32x4 we0 = *(const LAS f32x4*)(scw + 192 + ks * 32 + 8 * fq), we1 = *(const LAS f32x4*)(scw + 192 + ks * 32 + 8 * fq + 4);
                const unsigned bb = lds_addr(Bs) + (ks * 32 + 8 * fq) * SD_CLD + tr_lane(lane, SD_CLD);
                const bf16x8 xw0 = scale_frag(xf0, we0, we1), xw1 = scale_frag(xf1, we0, we1);
#pragma unroll
                for (int n4 = 0; n4 < 2; ++n4) { bf16x8 bfa[4]; tr_frags4<32, 4 * SD_CLD>(bb + n4 * 128, bfa);
#pragma unroll
                  for (int n1 = 0; n1 < 4; ++n1) { const int nt = n4 * 4 + n1;
                    st[nt][0] = MFMA16(bfa[n1], xw0, st[nt][0]); st[nt][1] = MFMA16(bfa[n1], xw1, st[nt][1]); } }
            }
            bf16* ylane = Yo + (2 * half) * 16 + 4 * fq; asm volatile("" : "+v"(ylane));
#pragma unroll
            for (int tt = 0; tt < 4; ++tt) { const int t = tt * 16 + fr; bf16* yr = ylane + (ptrdiff_t)(dir ? (R0 + 63 - t) : (R0 + t)) * 1024;
#pragma unroll
                for (int pt = 0; pt < 2; ++pt) { v2u w; w.x = pk2(acc[tt][pt][0], acc[tt][pt][1]); w.y = pk2(acc[tt][pt][2], acc[tt][pt][3]); *(v2u*)(yr + pt * 16) = w; } }
        }
        __syncthreads();
    }
#undef SDC_LOAD
}
__device__ __forceinline__ void ssd_chunk_unit(KArgs& a, int l, int unit, LAS unsigned char* lds, int tid) {
    if ((unit >> 2) & 1) { asm volatile("" : "+v"(tid)); ssd_chunk_unit_d<1>(a, l, unit, lds, tid); } else { asm volatile("" : "+v"(tid)); ssd_chunk_unit_d<0>(a, l, unit, lds, tid); }
}

constexpr int AT_KLD = 272, ATO_V = 17408, ATO_BUF = 34816;
__device__ __forceinline__ void attn_unit(KArgs& a, int l, int bl, int j0, int g, LAS unsigned char* lds, int tid) {
    const int lane = tid & 63, wid = __builtin_amdgcn_readfirstlane(tid >> 6), fr = lane & 15, fq = lane >> 4;
    const int hh = wid >> 1, qh = wid & 1, head = g * 4 + hh;
    const bool is_main = j0 >= CTXL; const int t0 = j0 - CTXL;
    const bf16* Ub = (const bf16*)(a.ws + WS_U) + (size_t)bl * RB * NU;
    int i_lo = 0, ntl = 0;
    if (is_main) { i_lo = (t0 < 128) ? (128 - t0) / 64 : 0; const int i_hi = (2176 - t0) / 64 < 5 ? (2176 - t0) / 64 : 5; ntl = i_hi - i_lo; }
    const int ntiles = ntl + 4;
    bf16x8 qf[2][4];
    const bf16* QKb = (const bf16*)(a.ws + WS_QK) + (size_t)bl * RB * 1280;
#pragma unroll
    for (int qt = 0; qt < 2; ++qt) { const int jr = j0 + qh * 32 + qt * 16 + fr; const bf16* qr = is_main ? QKb + (size_t)jr * 1280 + head * 128 : Ub + (size_t)jr * NU + UQ + head * 128;
#pragma unroll
        for (int ks = 0; ks < 4; ++ks) { float q[8]; unpack8(*(const v4u*)(qr + ks * 32 + 8 * fq), q);
            v4u w; w.x = pk2(q[0] * 0.12751743f, q[1] * 0.12751743f); w.y = pk2(q[2] * 0.12751743f, q[3] * 0.12751743f);
            w.z = pk2(q[4] * 0.12751743f, q[5] * 0.12751743f); w.w = pk2(q[6] * 0.12751743f, q[7] * 0.12751743f);
            qf[qt][ks] = __builtin_bit_cast(bf16x8, w); } }
    const float sink = a.in[10][l * 8 + head] * 1.44269504f;
    float m[2] = {sink, sink}, ls[2] = {(fq == 0) ? 1.0f : 0.0f, (fq == 0) ? 1.0f : 0.0f};
    f32x4 O[2][8];
#pragma unroll
    for (int qt = 0; qt < 2; ++qt)
#pragma unroll
        for (int dt = 0; dt < 8; ++dt) O[qt][dt] = (f32x4){0.f, 0.f, 0.f, 0.f};
    v4u pk[2], pv[2];
#define AT_LOAD(it_) do { const int it2 = (it_); const int krow0 = (it2 < ntl) ? (CTXL + t0 - 128 + 64 * (i_lo + it2)) : 64 * (it2 - ntl); \
        _Pragma("unroll") for (int i = 0; i < 2; ++i) { const int id = tid + 512 * i; const bf16* kr = Ub + (size_t)(krow0 + (id >> 4)) * NU + g * 128 + (id & 15) * 8; \
            pk[i] = (it2 < ntl) ? *(const v4u*)(QKb + (size_t)(krow0 + (id >> 4)) * 1280 + 1024 + g * 128 + (id & 15) * 8) : *(const v4u*)(kr + UK); pv[i] = *(const v4u*)(kr + UV); } } while (0)
    AT_LOAD(0);
    const int tid_outer = tid;
    for (int it = 0; it < ntiles; ++it) {
        int tid = tid_outer; asm volatile("" : "+v"(tid));
        const int lane = tid & 63, fr = lane & 15, fq = lane >> 4;
        LAS unsigned char* kb = lds + (it & 1) * ATO_BUF; LAS unsigned char* vb = kb + ATO_V;
        const bool local = it < ntl; const int k0 = t0 - 128 + 64 * (i_lo + it);
#pragma unroll
        for (int i = 0; i < 2; ++i) { const int id = tid + 512 * i, key = id >> 4, c16 = id & 15;
            const v4u kw = pk[i];
            *(LAS v4u*)(kb + key * AT_KLD + c16 * 16) = kw;
            *(LAS v4u*)(vb + key * AT_KLD + c16 * 16) = pv[i]; }
        if (it + 1 < ntiles) AT_LOAD(it + 1);
        __syncthreads();
        f32x4 S[2][4];
#pragma unroll
        for (int qt = 0; qt < 2; ++qt)
#pragma unroll
            for (int kt = 0; kt < 4; ++kt) S[qt][kt] = (f32x4){0.f, 0.f, 0.f, 0.f};
#pragma unroll
        for (int ks = 0; ks < 4; ++ks)
#pragma unroll
            for (int kt = 0; kt < 4; ++kt) { const bf16x8 kf = ldfrag(kb, kt * 16 + fr, AT_KLD, ks * 64 + fq * 16); S[0][kt] = MFMA16(kf, qf[0][ks], S[0][kt]); S[1][kt] = MFMA16(kf, qf[1][ks], S[1][kt]); }
        __builtin_amdgcn_sched_barrier(0);
        bf16x8 pf[2][2];
#pragma unroll
        for (int qt = 0; qt < 2; ++qt) {
            if (local) { const int pq = t0 + qh * 32 + qt * 16 + fr;
#pragma unroll
                for (int kt = 0; kt < 4; ++kt)
#pragma unroll
                    for (int r = 0; r < 4; ++r) { const int dlt = pq - (k0 + kt * 16 + 4 * fq + r); if (dlt > 128 || dlt < -128) S[qt][kt][r] = -INFINITY; } }
            float mx = fmaxf(fmaxf(fmaxf(S[qt][0][0], S[qt][0][1]), fmaxf(S[qt][0][2], S[qt][0][3])), fmaxf(fmaxf(S[qt][1][0], S[qt][1][1]), fmaxf(S[qt][1][2], S[qt][1][3])));
            mx = fmaxf(mx, fmaxf(fmaxf(fmaxf(S[qt][2][0], S[qt][2][1]), fmaxf(S[qt][2][2], S[qt][2][3])), fmaxf(fmaxf(S[qt][3][0], S[qt][3][1]), fmaxf(S[qt][3][2], S[qt][3][3]))));
            mx = fmaxf(mx, shx(mx, 16)); mx = fmaxf(mx, shx(mx, 32));
            const float mn = fmaxf(m[qt], mx), alpha = __builtin_amdgcn_exp2f(m[qt] - mn); m[qt] = mn;
            float psum = 0.f;
#pragma unroll
            for (int kt = 0; kt < 4; ++kt)
#pragma unroll
                for (int r = 0; r < 4; ++r) { const float p = __builtin_amdgcn_exp2f(S[qt][kt][r] - mn); S[qt][kt][r] = p; psum += p; }
            ls[qt] = ls[qt] * alpha + psum;
#pragma unroll
            for (int dt = 0; dt < 8; ++dt) O[qt][dt] *= alpha;
#pragma unroll
            for (int k2 = 0; k2 < 2; ++k2) { v4u pw; pw.x = pk2(S[qt][2 * k2][0], S[qt][2 * k2][1]); pw.y = pk2(S[qt][2 * k2][2], S[qt][2 * k2][3]); pw.z = pk2(S[qt][2 * k2 + 1][0], S[qt][2 * k2 + 1][1]); pw.w = pk2(S[qt][2 * k2 + 1][2], S[qt][2 * k2 + 1][3]);
                pf[qt][k2] = __builtin_bit_cast(bf16x8, pw); }
        }
#pragma unroll
        for (int k2 = 0; k2 < 2; ++k2) {
            const unsigned va = lds_addr(vb) + (k2 * 32 + 4 * fq) * AT_KLD + tr_lane(lane, AT_KLD);
#pragma unroll
            for (int d4 = 0; d4 < 2; ++d4) { bf16x8 vfa[4]; tr_frags4<32, 16 * AT_KLD>(va + d4 * 128, vfa);
#pragma unroll
                for (int d1 = 0; d1 < 4; ++d1) { O[0][d4 * 4 + d1] = MFMA16(vfa[d1], pf[0][k2], O[0][d4 * 4 + d1]); O[1][d4 * 4 + d1] = MFMA16(vfa[d1], pf[1][k2], O[1][d4 * 4 + d1]); } }
            __builtin_amdgcn_sched_barrier(0);
        }
    }
#undef AT_LOAD
#pragma unroll
    for (int qt = 0; qt < 2; ++qt) {
        float lt = ls[qt]; lt += shx(lt, 16); lt += shx(lt, 32); const float inv = 1.0f / lt;
        const int jr = j0 + qh * 32 + qt * 16 + fr; const bf16* zr = Ub + (size_t)jr * NU + UAZ + head * 128; bf16* orow = (bf16*)(a.ws + WS_OBR) + (size_t)(bl * RB + jr) * LDK3 + head * 128;
#pragma unroll
        for (int dt = 0; dt < 8; ++dt) { const v2u zw = *(const v2u*)(zr + dt * 16 + 4 * fq); const f32x4 o = O[qt][dt] * inv;
            const float z0 = bflo(zw.x), z1 = bfhi(zw.x), z2 = bflo(zw.y), z3 = bfhi(zw.y);
            v2u w; w.x = pk2(o[0] * z0 * fsig(z0), o[1] * z1 * fsig(z1)); w.y = pk2(o[2] * z2 * fsig(z2), o[3] * z3 * fsig(z3));
            *(v2u*)(orow + dt * 16 + 4 * fq) = w; }
    }
}
__device__ __forceinline__ int phase_D_mixers(KArgs& a, int l, unsigned* ctr, LAS unsigned char* lds, int tid) {
    const int n_att = NBP * 64 + ((l == 0) ? NBP * 8 : 0);
    const int n_mix = 160 + n_att;
    volatile LAS int* MISC = (volatile LAS int*)(lds + MISC_OFF);
    for (;;) {
        __syncthreads();
        if (tid == 0) MISC[20] = (int)__hip_atomic_fetch_add(ctr, 1u, __ATOMIC_RELAXED, __HIP_MEMORY_SCOPE_AGENT);
        __syncthreads();
        const int u = MISC[20];
        if (u >= n_mix) break;
        asm volatile("" : "+v"(tid));
        if (u < 128) { for (int rp = 0; rp < ((MK_DUP == 10) ? 2 : 1); ++rp) { mlstm_chunk_unit(a, l, u, lds, tid); if (MK_DUP == 10) __syncthreads(); } }
        else if (u < 160) { for (int rp = 0; rp < ((MK_DUP == 11) ? 2 : 1); ++rp) { ssd_chunk_unit(a, l, u - 128, lds, tid); if (MK_DUP == 11) __syncthreads(); } }
        else { for (int rp = 0; rp < ((MK_DUP == 12) ? 2 : 1); ++rp) {
            const int au = u - 160;
            if (au < NBP * 64) attn_unit(a, l, au >> 6, CTXL + ((au >> 1) & 31) * 64, au & 1, lds, tid);
            else { const int cu = au - NBP * 64; attn_unit(a, l, cu >> 3, ((cu >> 1) & 3) * 64, cu & 1, lds, tid); }
            if (MK_DUP == 12) __syncthreads(); }
        }
    }
    return n_mix;
}
struct ERow { v4u hf[2], hb[2], o[2], z[2], xc[2], sz[2], yf[2], yb[2]; };
__device__ __forceinline__ void e_load(KArgs& a, int rl, int lane, ERow& r) {
    const bf16* ur = (const bf16*)(a.ws + WS_U) + (size_t)rl * NU; const bf16* S = (const bf16*)(a.ws + WS_SC) + (size_t)rl * 1024;
#pragma unroll
    for (int q = 0; q < 2; ++q) { const int col = q * 512 + lane * 8;
        r.hf[q] = *(const v4u*)(S + col); r.hb[q] = *(const v4u*)(S + (size_t)RP * 1024 + col); r.yf[q] = *(const v4u*)(S + (size_t)2 * RP * 1024 + col); r.yb[q] = *(const v4u*)(S + (size_t)3 * RP * 1024 + col);
        r.o[q] = *(const v4u*)(ur + UMO + col); r.z[q] = *(const v4u*)(ur + UMZ + col); r.sz[q] = *(const v4u*)(ur + USZ + col);
        r.xc[q] = *(const v4u*)((const bf16*)(a.ws + WS_XC) + (size_t)rl * 1536 + col); }
}
__device__ __forceinline__ float half_sum(float v) {
    const int l4 = lane4_l();
#pragma unroll
    for (int o = 1; o < 32; o <<= 1) v += bperm_f(l4 ^ (o << 2), v);
    return v;
}
__device__ __forceinline__ void e_finish(KArgs& a, int l, int rl, int lane, const ERow& r) {
    bf16* orow = (bf16*)(a.ws + WS_OBR) + (size_t)rl * LDK3;
#pragma unroll
    for (int q = 0; q < 2; ++q) { const int col = q * 512 + lane * 8;
        float hf[8], hb[8], ov[8], zv[8], v[8]; unpack8(r.hf[q], hf); unpack8(r.hb[q], hb); unpack8(r.o[q], ov); unpack8(r.z[q], zv);
        float ss = 0.f;
#pragma unroll
        for (int k = 0; k < 8; ++k) { v[k] = fsig(ov[k]) * (hf[k] + hb[k]); ss += v[k] * v[k]; }
        ss = half_sum(ss); const float rn = 1.0f / sqrtf(ss * (1.0f / 256.0f) + EPS);
        const f32x4 g0 = *(const f32x4*)(a.in[12] + l * 1024 + col), g1 = *(const f32x4*)(a.in[12] + l * 1024 + col + 4);
        const float gg[8] = {g0.x, g0.y, g0.z, g0.w, g1.x, g1.y, g1.z, g1.w};
#pragma unroll
        for (int k = 0; k < 8; ++k) v[k] = v[k] * rn * gg[k] * zv[k] * fsig(zv[k]);
        v4u w; w.x = pk2(v[0], v[1]); w.y = pk2(v[2], v[3]); w.z = pk2(v[4], v[5]); w.w = pk2(v[6], v[7]);
        *(v4u*)(orow + 1024 + col) = w; }
    float yv[2][8]; float ssq = 0.f;
#pragma unroll
    for (int q = 0; q < 2; ++q) { const int col = q * 512 + lane * 8;
        float yf[8], yb[8], xs[8], zv[8]; unpack8(r.yf[q], yf); unpack8(r.yb[q], yb); unpack8(r.xc[q], xs); unpack8(r.sz[q], zv);
        const float dsk = a.in[17][l * 16 + (col >> 6)];
#pragma unroll
        for (int k = 0; k < 8; ++k) { const float t = (yf[k] + yb[k] + dsk * xs[k]) * zv[k] * fsig(zv[k]); yv[q][k] = t; ssq += t * t; } }
    ssq = wave_sum(ssq); const float rn = 1.0f / sqrtf(ssq * (1.0f / 1024.0f) + EPS);
#pragma unroll
    for (int q = 0; q < 2; ++q) { const int col = q * 512 + lane * 8;
        const f32x4 g0 = *(const f32x4*)(a.in[18] + l * 1024 + col), g1 = *(const f32x4*)(a.in[18] + l * 1024 + col + 4);
        v4u w; w.x = pk2(yv[q][0] * rn * g0.x, yv[q][1] * rn * g0.y); w.y = pk2(yv[q][2] * rn * g0.z, yv[q][3] * rn * g0.w);
        w.z = pk2(yv[q][4] * rn * g1.x, yv[q][5] * rn * g1.y); w.w = pk2(yv[q][6] * rn * g1.z, yv[q][7] * rn * g1.w);
        *(v4u*)(orow + 2048 + col) = w; }
}
__device__ __forceinline__ void phase_E(KArgs& a, int l, int lane, int gw, int NGW) {
    const int nrows = (l == 0) ? RP : NBP * SEQ;
#define E_ROW(i_) ((l == 0) ? (i_) : (((i_) / SEQ) * RB + CTXL + ((i_) % SEQ)))
    for (int i = gw; i < nrows; i += 2 * NGW) {
        const int r0 = E_ROW(i), i1 = i + NGW; const bool two = i1 < nrows; const int r1 = two ? E_ROW(i1) : r0;
        ERow A, B;
        e_load(a, r0, lane, A); if (two) e_load(a, r1, lane, B);
        e_finish(a, l, r0, lane, A);
        if (two) e_finish(a, l, r1, lane, B);
    }
#undef E_ROW
}
__device__ __forceinline__ void phase_C2(KArgs& a, int l, LAS unsigned char* lds, int tid, int G, int c) {
    constexpr int N_ML = NBP * 8, N_SD = NBP * 2 * 36 * 16 / 8, N_CV = RP / 32, N_RP = NBP * 64;
    for (int u = c; u < N_ML + N_SD + N_CV + N_RP; u += G) {
        asm volatile("" : "+v"(tid));
        if (u < N_ML) mlsc_unit(a, l, u, lds, tid);
        else if (u < N_ML + N_SD) sdsc_task(a, l, (u - N_ML) * 8 + __builtin_amdgcn_readfirstlane(tid >> 6), tid & 63);
        else if (u < N_ML + N_SD + N_CV) conv_unit(a, l, u - N_ML - N_SD, tid);
        else rope_unit(a, u - N_ML - N_SD - N_CV, tid);
    }
}

constexpr int N_GATE_STATIC = 5 * 256 - NMT * 29;
constexpr int N_PHASES = 2 + NPASS * 14 - (NPASS - 1);
__global__ void __launch_bounds__(512, 2) mk_fwd(Args a_unused) {
    extern __shared__ __attribute__((aligned(16))) unsigned char lds_raw[];
    LAS unsigned char* lds = (LAS unsigned char*)lds_raw;
    KArgs* const kp = (KArgs*)__builtin_amdgcn_kernarg_segment_ptr();
#define FRESH(name) KArgs* name = kp; asm volatile("" : "+s"(name)); int tid = threadIdx.x; asm volatile("" : "+v"(tid)); (void)tid
#define LANE (tid & 63)
#define WAVE (__builtin_amdgcn_readfirstlane(tid >> 6))
#define GG ((int)gridDim.x)
#define CC ((int)blockIdx.x)
    for (int u = threadIdx.x; u < (LDS_BYTES - MISC_OFF) / 4; u += 512) ((LAS unsigned*)(lds + MISC_OFF))[u] = 0u;
    __syncthreads();
    int ph_lo, ph_hi;
    { FRESH(a); ph_lo = a->ph_lo; ph_hi = a->ph_hi;
      if (ph_hi - ph_lo > 1) (void)xcd_barrier_post((unsigned*)(a->ws + WS_CTL) + CW_BAR, (volatile LAS unsigned*)(lds + MISC_OFF) + 8); }
    int ph = 0;
#define IN_PH() (ph_lo <= ph && ph < ph_hi)
#define REPS(k) ((MK_DUP == (k)) ? 2 : 1)
#define SEAM() do { if (ph + 1 < ph_hi || MK_DUP >= 0) { KArgs* ab = kp; asm volatile("" : "+s"(ab)); XcdBarrier bar; bar.bar = (unsigned*)(ab->ws + WS_CTL) + CW_BAR; bar.x = xb_xcc_id(); bar.st = (volatile LAS unsigned*)(lds + MISC_OFF) + 8; xcd_barrier(bar); } } while (0)
    if (IN_PH()) for (int rep = 0; rep < REPS(8); ++rep) { FRESH(a); phase_p0(*a, lds, tid, LANE, WAVE, GG, CC); SEAM(); }
    ++ph;
    for (int pass = 0; pass < NPASS; ++pass) {
        if (pass == 0) { if (IN_PH()) { FRESH(a); phase_B(*a, 0, lds, LANE, CC * 8 + WAVE, GG * 8); SEAM(); } ++ph; }
        for (int l = 0; l < 2; ++l) {
            if (IN_PH()) for (int rep = 0; rep < REPS(0); ++rep) {
                FRESH(a);
                pg8::Gemm g{(const bf16*)(a->ws + ws_hb(pass)), (const bf16*)(a->ws + WS_W1T) + (size_t)l * N1 * LDK, RP, N1, 2048, LDK};
                pg8::TileOrder S{NMT, 29, 0, 1, (l == 0) ? NMT : NBP * 8, 12, (l == 0) ? 0 : 1, -1, N_GATE_STATIC, GG, CC};
                pg8::EpiC E{(bf16*)(a->ws + WS_U), (float*)(a->ws + WS_US), a->in[9] + l * 6144};
                pg8::gemm_phase<pg8::EpiC, pg8::TileOrder, true, true>(lds, g, S, E);
                SEAM();
            }
            ++ph;
            if (IN_PH()) for (int rep = 0; rep < REPS(1); ++rep) { FRESH(a); phase_C2(*a, l, lds, tid, GG, CC); SEAM(); }
            ++ph;
            if (IN_PH()) {
                FRESH(a);
                unsigned* ctr = (unsigned*)(a->ws + WS_CTL) + CW_QUEUE + 64 * (pass * 2 + l);
                (void)phase_D_mixers(*a, l, ctr, lds, tid);
                volatile LAS int* MISC = (volatile LAS int*)(lds + MISC_OFF);
                pg8::EpiC E{(bf16*)(a->ws + WS_U), (float*)(a->ws + WS_US), a->in[9] + l * 6144};
                { pg8::Gemm g{(const bf16*)(a->ws + ws_hb(pass)), (const bf16*)(a->ws + WS_W1T) + (size_t)l * N1 * LDK, RP, N1, 2048, LDK};
                  pg8::QueueOrder S{(unsigned*)(a->ws + WS_CTL) + CW_QUEUE8 + 64 * 8 * (pass * 2 + l), (int)(xb_xcc_id() & 7u), (l == 0) ? NMT : NBP * 8, (l == 0) ? 0 : 1, N_GATE_STATIC, 0, 0, 0, 0, MISC + 16};
                  __syncthreads();
                  if (tid == 0) { MISC[20] = S.draw(); MISC[17] = S.draw(); }
                  __syncthreads();
                  S.first = MISC[20];
                  pg8::gemm_phase<pg8::EpiC, pg8::QueueOrder, true, true>(lds, g, S, E); }
                { FRESH(a6);
                  pg8::Gemm g8{(const bf16*)(a6->ws + ws_hb8(pass)), (const bf16*)(a6->ws + WS_WG8 + (size_t)l * 6144 * LD8) - (size_t)40 * 256 * (LD8 / 2), RP, N1, 1024, LD8 / 2};
                  pg8::QueueOrder S{(unsigned*)(a6->ws + WS_CTL) + CW_QUEUE8 + 64 * 8 * (8 + pass * 2 + l), (int)(xb_xcc_id() & 7u), 0, 0, 0, (l == 0) ? NMT : NBP * 8, (l == 0) ? 0 : 1, 0, 0, MISC + 16};
                  __syncthreads();
                  if (tid == 0) { MISC[20] = S.draw(); MISC[17] = S.draw(); }
                  __syncthreads();
                  S.first = MISC[20];
                  pg8::gemm_phase<pg8::EpiC, pg8::QueueOrder, true, true, true>(lds, g8, S, E); }
                SEAM();
            }
            ++ph;
            if (IN_PH()) for (int rep = 0; rep < REPS(3); ++rep) { FRESH(a); phase_E(*a, l, LANE, CC * 8 + WAVE, GG * 8); SEAM(); }
            ++ph;
            if (IN_PH()) for (int rep = 0; rep < ((l == 0) ? REPS(4) * REPS(40) : REPS(4) * REPS(41) * REPS(42)); ++rep) {
                FRESH(a);
                pg8::Gemm g{(const bf16*)(a->ws + WS_OBR), (const bf16*)(a->ws + WS_WBT) + (size_t)l * 2048 * LDK3, RP, 2048, 3072, LDK3};
                pg8::TileOrder S{(l == 0) ? NMT : NBP * 8, 8, (l == 0) ? 0 : 1, 0, 0, 0, 0, 0, 0, GG, CC};
                pg8::EpiF E{(const bf16*)(a->ws + WS_U), (bf16*)(a->ws + WS_MG), (MK_DUP == 42 && l == 1 && rep == 0) ? 1 : 0};
                pg8::gemm_phase<pg8::EpiF, pg8::TileOrder, true, true>(lds, g, S, E);
                if (l == 0) { const int skip = (GG > 64) ? 32 : 0; if (CC >= skip) { FRESH(a2); if (pass == 0) p0_weights(*a2, 1, lds, LANE, WAVE, (CC - skip) * 8 + WAVE, (GG - skip) * 8);
                    if (pass > 0) phase_H(*a2, pass - 1, 1, lds, LANE, (CC - skip) * 8 + WAVE, (GG - skip) * 8); } }
                SEAM();
            }
            ++ph;
            if (IN_PH()) for (int rep = 0; rep < ((l == 0) ? REPS(5) * REPS(50) : REPS(5) * REPS(51)); ++rep) {
                FRESH(a);
                pg8::Gemm g{(const bf16*)(a->ws + WS_MG), (const bf16*)(a->ws + WS_WOT) + (size_t)l * 2048 * LDK, RP, 2048, 2048, LDK};
                pg8::TileOrder S{(l == 0) ? NMT : NBP * 8, 8, (l == 0) ? 0 : 1, 0, 0, 0, 0, 0, 0, GG, CC};
                pg8::EpiG E{(bf16*)(a->ws + WS_Y), 2048};
                pg8::gemm_phase<pg8::EpiG, pg8::TileOrder, true, true>(lds, g, S, E);
                if (l == 0 && pass + 1 < NPASS) { const int skip = (GG > 64) ? 32 : 0; if (CC >= skip) { FRESH(a2); phase_B(*a2, pass + 1, lds, LANE, (CC - skip) * 8 + WAVE, (GG - skip) * 8); } }
                SEAM();
            }
            ++ph;
            if (l == 0 || pass == NPASS - 1) { if (IN_PH()) for (int rep = 0; rep < ((l == 0) ? REPS(6) : 1); ++rep) { FRESH(a); phase_H(*a, pass, l, lds, LANE, CC * 8 + WAVE, GG * 8); SEAM(); } ++ph; }
        }
    }
#undef IN_PH
#undef SEAM
}

extern "C" void kernel_launch(void* const* d_in, const int* in_sizes, int n_in, void* d_out, int out_size, void* d_ws, size_t ws_size, hipStream_t stream) {
    static int grid = 0;
    if (grid == 0) {
        if (n_in != 22 || out_size != NBATCH * SEQ * DM || ws_size < WS_END) { fprintf(stderr, "kernel_launch: unexpected problem: n_in %d out %d ws %zu (need %zu)\n", n_in, out_size, ws_size, (size_t)WS_END); grid = -1; return; }
        int dev = 0, cus = 0, per_cu = 0;
        if (hipGetDevice(&dev) != hipSuccess || hipDeviceGetAttribute(&cus, hipDeviceAttributeMultiprocessorCount, dev) != hipSuccess) { grid = -1; return; }
        if (hipFuncSetAttribute((const void*)mk_fwd, hipFuncAttributeMaxDynamicSharedMemorySize, LDS_BYTES) != hipSuccess) { fprintf(stderr, "kernel_launch: hipFuncSetAttribute failed\n"); grid = -1; return; }
        if (hipOccupancyMaxActiveBlocksPerMultiprocessor(&per_cu, (const void*)mk_fwd, 512, LDS_BYTES) != hipSuccess || per_cu < 1) fprintf(stderr, "kernel_launch: occupancy query reports %d\n", per_cu);
        (void)hipGetLastError();
        grid = cus;
    }
    if (grid < 0) return;
    if (hipMemsetAsync((char*)d_ws + WS_CTL, 0, CTL_ZERO_BYTES, stream) != hipSuccess) return;
    Args a{};
    for (int i = 0; i < 22; ++i) a.in[i] = (const float*)d_in[i];
    a.out = (float*)d_out; a.ws = (unsigned char*)d_ws;
#if MK_N_LAUNCHES == 1
    a.ph_lo = 0; a.ph_hi = N_PHASES;
    hipLaunchKernelGGL(mk_fwd, dim3(grid), dim3(512), LDS_BYTES, stream, a);
#else
    for (int ph = 0; ph < N_PHASES; ++ph) { a.ph_lo = ph; a.ph_hi = ph + 1; hipLaunchKernelGGL(mk_fwd, dim3(grid), dim3(512), LDS_BYTES, stream, a); }
#endif
}
```

```cpp
#include <hip/hip_runtime.h>
#include <cstdio>
#include <cstdint>

#ifndef MK_N_LAUNCHES
#define MK_N_LAUNCHES 1
#endif

#ifndef MK_DUP
#define MK_DUP -1
#endif
#define GAS __attribute__((address_space(1)))
typedef unsigned short bf16;
typedef unsigned v4u __attribute__((ext_vector_type(4)));
typedef unsigned v2u __attribute__((ext_vector_type(2)));
typedef float f32x4 __attribute__((ext_vector_type(4)));
typedef float f32x2 __attribute__((ext_vector_type(2)));
typedef short bf16x8 __attribute__((ext_vector_type(8)));

constexpr int DM = 2048, NBATCH = 16, SEQ = 2048, CTXL = 256, RB = SEQ + CTXL;
constexpr int NBP = 4, NPASS = NBATCH / NBP, RP = NBP * RB;
constexpr int NMT = RP / 256;
constexpr float EPS = 1e-6f;
constexpr int NU = 16384;
constexpr int UQ = 0, UK = 1024, UV = 1280, UAZ = 1536, UMQ = 2560, UMK = 3584, UMV = 4608, UMO = 5632, UMZ = 6656, UXBC = 7680, USZ = 9216, UG = 10240;
constexpr int N1 = 16640;
constexpr int USL = 64;
constexpr int NIN = 10288;

constexpr size_t MiB = 1u << 20;
constexpr size_t WS_CTL = 0, CTL_ZERO_BYTES = 1 * MiB;
constexpr size_t WS_MOD = 1 * MiB;
constexpr size_t WS_ROPE = 2 * MiB;
constexpr int LDK = 2048 + 64, LDK3 = 3072 + 64;
constexpr size_t WS_W1T = 4 * MiB;
constexpr size_t WS_WBT = 140 * MiB;
constexpr size_t WS_WOT = 166 * MiB;
constexpr size_t WS_HB = 184 * MiB;
constexpr size_t WS_U = 222 * MiB;
constexpr size_t WS_US = 510 * MiB;
constexpr size_t WS_SC = 514 * MiB;
constexpr size_t WS_OBR = 658 * MiB;
constexpr size_t WS_MG = 714 * MiB;
constexpr size_t WS_Y = 752 * MiB;
constexpr size_t WS_XC = 824 * MiB;
constexpr size_t WS_MSC = 852 * MiB;
constexpr size_t WS_SSC = 854 * MiB;
constexpr size_t WS_QK = 860 * MiB;
constexpr size_t WS_HB2 = 884 * MiB;
constexpr int LD8 = 2048 + 128;
constexpr size_t WS_HB8 = 922 * MiB;
constexpr size_t WS_WG8 = 962 * MiB;
constexpr size_t WS_SA8 = 988 * MiB;
constexpr size_t WS_END = 989 * MiB;
constexpr int CW_WMAX = 2048;
static_assert(WS_W1T + (size_t)2 * N1 * LDK * 2 <= WS_WBT && WS_WBT + (size_t)2 * 2048 * LDK3 * 2 <= WS_WOT && WS_WOT + (size_t)2 * 2048 * LDK * 2 <= WS_HB && WS_HB + (size_t)RP * LDK * 2 <= WS_U && WS_U + (size_t)RP * NU * 2 <= WS_US &&
              WS_SC + (size_t)4 * RP * 1024 * 4 <= WS_OBR && WS_OBR + (size_t)RP * LDK3 * 2 <= WS_MG && WS_MG + (size_t)RP * LDK * 2 <= WS_Y && WS_Y + (size_t)RP * 2048 * 4 <= WS_XC && WS_XC + (size_t)RP * 1536 * 2 <= WS_MSC &&
              WS_MSC + (size_t)NBP * 8 * 36 * 384 * 4 <= WS_SSC && WS_SSC + (size_t)NBP * 2 * 36 * 16 * 320 * 4 <= WS_QK && WS_QK + (size_t)RP * 1280 * 2 <= WS_HB2 && WS_HB2 + (size_t)RP * LDK * 2 <= WS_END, "ws map");
constexpr int CW_BAR = 4096;
constexpr int CW_DONE = 32768;
constexpr int CW_QUEUE8 = 65536;
constexpr int CW_QUEUE = 16384;

constexpr int RING_BYTES = 131072;
constexpr int LDS_BYTES = 147456;
constexpr int MISC_OFF = LDS_BYTES - 256;

__device__ __forceinline__ unsigned pk2(float lo, float hi) { unsigned r; asm("v_cvt_pk_bf16_f32 %0, %1, %2" : "=v"(r) : "v"(lo), "v"(hi)); return r; }
__device__ __forceinline__ unsigned f2bf(float f) { return pk2(f, 0.f) & 0xffffu; }
__device__ __forceinline__ float bf2f(bf16 h) { return __builtin_bit_cast(float, (unsigned)h << 16); }
__device__ __forceinline__ float bflo(unsigned w) { return __builtin_bit_cast(float, w << 16); }
__device__ __forceinline__ float bfhi(unsigned w) { return __builtin_bit_cast(float, w & 0xffff0000u); }
__device__ __forceinline__ int lane4_l() { int ln = __builtin_amdgcn_mbcnt_hi(-1, __builtin_amdgcn_mbcnt_lo(-1, 0)) << 2; asm volatile("" : "+v"(ln)); return ln; }
__device__ __forceinline__ float bperm_f(int addr4, float v) { return __builtin_bit_cast(float, __builtin_amdgcn_ds_bpermute(addr4, __builtin_bit_cast(int, v))); }
__device__ __forceinline__ float shx(float v, int mask) { return bperm_f(lane4_l() ^ (mask << 2), v); }
__device__ __forceinline__ float shup(float v, int d) { const int l4 = lane4_l(); return bperm_f(l4 >= (d << 2) ? l4 - (d << 2) : l4, v); }
__device__ __forceinline__ float shidx(float v, int src) { return bperm_f(src << 2, v); }
__device__ __forceinline__ float wave_sum(float v) {
    const int l4 = lane4_l();
#pragma unroll
    for (int o = 1; o < 64; o <<= 1) v += bperm_f(l4 ^ (o << 2), v);
    return v;
}
__device__ __forceinline__ float wave_max(float v) {
    const int l4 = lane4_l();
#pragma unroll
    for (int o = 1; o < 64; o <<= 1) v = fmaxf(v, bperm_f(l4 ^ (o << 2), v));
    return v;
}
__device__ __forceinline__ float sigmoid_f(float x) { return 1.0f / (1.0f + expf(-x)); }
__device__ __forceinline__ float silu_f(float x) { return x / (1.0f + expf(-x)); }
__device__ __forceinline__ float softplus_f(float x) { return fmaxf(x, 0.f) + log1pf(expf(-fabsf(x))); }
__device__ __forceinline__ float logsigmoid_f(float x) { return -softplus_f(-x); }
__device__ __forceinline__ size_t ws_hb(int pass) { return (pass & 1) ? WS_HB2 : WS_HB; }
__device__ __forceinline__ size_t ws_hb8(int pass) { return WS_HB8 + ((pass & 1) ? 20 * MiB : 0); }
__device__ __forceinline__ size_t ws_sa8(int pass) { return WS_SA8 + ((pass & 1) ? 64 * 1024 : 0); }
static_assert((size_t)RP * LD8 <= 20 * MiB && WS_HB8 + 40 * MiB <= WS_WG8 && WS_WG8 + (size_t)2 * 6144 * LD8 <= WS_END, "int8 ws map");
__device__ __forceinline__ float fsig(float x) { return __builtin_amdgcn_rcpf(1.0f + __builtin_amdgcn_exp2f(-1.44269504f * x)); }
__device__ __forceinline__ float ex2(float x) { return __builtin_amdgcn_exp2f(x); }
constexpr float L2E = 1.44269504088896f;

struct Args { const float* in[22]; float* out; unsigned char* ws; int ph_lo, ph_hi; };
typedef const __attribute__((address_space(4))) Args KArgs;

#define XB_TMO      128
#define XB_XCNT(j)  (256  + 64 * (j))
#define XB_XSUB(j)  (1280 + 64 * (j))
#define XB_XGEN(j)  (2304 + 64 * (j))
#define XB_TOP      3328
#define XB_TOPGEN   3392
#define XCD_BAR_WORDS 3456
#define XB_SPIN_CAP (1u << 25)
#define LAS __attribute__((address_space(3)))

__device__ __forceinline__ unsigned xb_ld(unsigned* p)              { return __hip_atomic_load(p, __ATOMIC_RELAXED, __HIP_MEMORY_SCOPE_AGENT); }
__device__ __forceinline__ unsigned xb_add(unsigned* p, unsigned v) { return __hip_atomic_fetch_add(p, v, __ATOMIC_RELAXED, __HIP_MEMORY_SCOPE_AGENT); }
__device__ __forceinline__ unsigned xb_xcc_id() { return (unsigned)__builtin_amdgcn_s_getreg((3 << 11) | 20) & 0xFu; }
#define XB_SPIN(cond, bar) do { unsigned _sp = 0; while (cond) { __builtin_amdgcn_s_sleep(1); \
    if ((++_sp & 255u) == 0u) { if (xb_ld(&(bar)[XB_TMO])) break; if (_sp > XB_SPIN_CAP) { atomicAdd(&(bar)[XB_TMO], 1u); break; } } } } while (0)

struct XcdBarrier {
    unsigned* bar; unsigned x;
    volatile LAS unsigned* st;
};

__device__ __forceinline__ XcdBarrier xcd_barrier_post(unsigned* bar, volatile LAS unsigned* st) {
    XcdBarrier b; b.bar = bar; b.x = xb_xcc_id(); b.st = st;
    if (threadIdx.x == 0) (void)xb_add(&bar[XB_XCNT(b.x)], 1u);
    return b;
}
__device__ __forceinline__ void xcd_barrier_complete(unsigned* bar, unsigned x, unsigned& nloc, unsigned& nx) {
    const unsigned G = gridDim.x * gridDim.y * gridDim.z;
    unsigned sum, cnt, mine, sp = 0u;
    for (;;) {
        sum = 0u; cnt = 0u; mine = 0u;
#pragma unroll
        for (unsigned j = 0; j < 16; ++j) { const unsigned c = xb_ld(&bar[XB_XCNT(j)]); sum += c; cnt += (c > 0u) ? 1u : 0u; mine = (j == x) ? c : mine; }
        if (sum == G) break;
        __builtin_amdgcn_s_sleep(1);
        if ((++sp & 255u) == 0u) { if (xb_ld(&bar[XB_TMO])) break; if (sp > XB_SPIN_CAP) { atomicAdd(&bar[XB_TMO], 1u); break; } }
    }
    nloc = mine > 0u ? mine : 1u; nx = cnt > 0u ? cnt : 1u;
}

__device__ __forceinline__ void xcd_barrier(const XcdBarrier& b) {
    asm volatile("s_waitcnt vmcnt(0)" ::: "memory");
    __syncthreads();
    if (threadIdx.x == 0) {
        unsigned* bar = b.bar;
        __builtin_amdgcn_s_waitcnt(0);
        unsigned nloc = b.st[0], nx = b.st[1];
        if (nloc == 0u) { xcd_barrier_complete(bar, b.x, nloc, nx); b.st[0] = nloc; b.st[1] = nx; }
        const unsigned old = xb_add(&bar[XB_XSUB(b.x)], 1u);
        const unsigned gen = old / nloc;
        if (old + 1u == (gen + 1u) * nloc) {
            __builtin_amdgcn_fence(__ATOMIC_RELEASE, "agent");
            asm volatile("s_waitcnt vmcnt(0)" ::: "memory");
            const unsigned og = xb_add(&bar[XB_TOP], 1u);
            const unsigned tg = og / nx;
            if (og + 1u == (tg + 1u) * nx) xb_add(&bar[XB_TOPGEN], 1u);
            else XB_SPIN(xb_ld(&bar[XB_TOPGEN]) == tg, bar);
            __builtin_amdgcn_fence(__ATOMIC_ACQUIRE, "agent");
            xb_add(&bar[XB_XGEN(b.x)], 1u);
            asm volatile("s_waitcnt vmcnt(0)" ::: "memory");
        } else {
            XB_SPIN(xb_ld(&bar[XB_XGEN(b.x)]) == gen, bar);
            __builtin_amdgcn_fence(__ATOMIC_ACQUIRE, "agent");
            asm volatile("s_waitcnt vmcnt(0)" ::: "memory");
        }
    }
    __syncthreads();
}


namespace pg8 {
#define PG8_LAS __attribute__((address_space(3)))
typedef unsigned short bf16_t;
typedef short bf16x8 __attribute__((ext_vector_type(8)));
typedef float f32x4 __attribute__((ext_vector_type(4)));
typedef unsigned u32x4 __attribute__((ext_vector_type(4)));
typedef int v4i_t __attribute__((ext_vector_type(4)));
constexpr int BM = 256, BK = 64, HALF = 128, HTB = HALF * BK * 2  , STAGE_BYTES = 8 * HTB, NXCD = 8, WGM = 8;

__host__ __device__ __forceinline__ int lds_byte(int r, int c) { const int st = (r >> 4) * 2 + (c >> 5), rr = r & 15, cc = c & 31, ob = rr * 64 + cc * 2; return st * 1024 + (ob ^ (((ob >> 9) & 1) << 5)); }
__host__ __device__ __forceinline__ void stage_rc(int b, int& R, int& C) { const int st = b / 1024, sb = b % 1024, swz = sb ^ (((sb >> 9) & 1) << 5); R = (st >> 1) * 16 + swz / 64; C = (st & 1) * 32 + (swz % 64) / 2; }
__host__ __device__ __forceinline__ int perm32(int rho) { const int n = rho >> 4, i = rho & 15; return 8 * (i >> 2) + 4 * n + (i & 3); }

struct Unit { int pm, pn; };
struct Gemm { const bf16_t* A; const bf16_t* Bt; int M, N, K, ld; };

__device__ __forceinline__ void rect_map(int L, int nM, int nN, int& pm, int& pn) {
    const int nwg = nM * nN; int wgid = L;
    { const int q = nwg / NXCD, r = nwg % NXCD, xcd = wgid % NXCD, off = wgid / NXCD; wgid = (xcd < r ? xcd * (q + 1) : r * (q + 1) + (xcd - r) * q) + off; }
    const int nig = WGM * nN, gid = wgid / nig, fm = gid * WGM, gsz = (nM - fm) < WGM ? (nM - fm) : WGM;
    pm = fm + ((wgid % nig) % gsz); pn = (wgid % nig) / gsz;
}
__device__ __forceinline__ int main_tile(int m) { return (m >> 3) * 9 + 1 + (m & 7); }
__device__ __forceinline__ int colA(int i) { return i < 22 ? i : (i < 28 ? i + 8 : 64); }
__device__ __forceinline__ int colB(int i) { return i < 8 ? 22 + i : 28 + i; }
struct TileOrder {
    int nM1, nN1, mo1, special1;
    int nM2, nN2, mo2, pn_off2;
    int lim2;
    int G, c;
    __device__ __forceinline__ bool next(int i, Unit& u) const {
        const int L = i * G + c, n1 = nM1 * nN1;
        if (L < n1) { int pm, pn; rect_map(L, nM1, nN1, pm, pn);
            if (special1 == 2 && (pm % 9) == 0 && (pn < 4 || (pn >= 6 && pn < 14))) { const int h = (pm / 9) * 12 + (pn < 4 ? pn : pn - 2); rect_map(lim2 + h, nM2, nN2, pm, pn);
                u.pm = mo2 ? main_tile(pm) : pm; u.pn = (pn_off2 < 0) ? colB(pn) : pn + pn_off2; return true; }
            u.pm = mo1 ? main_tile(pm) : pm; u.pn = special1 ? colA(pn) : pn; return true; }
        if (L < n1 + lim2) { int pm, pn; rect_map(L - n1, nM2, nN2, pm, pn); u.pm = mo2 ? main_tile(pm) : pm; u.pn = (pn_off2 < 0) ? colB(pn) : pn + pn_off2; return true; }
        return false;
    }
    __device__ __forceinline__ void a_ready(const Unit&) const {}
    __device__ __forceinline__ void done(const Unit&) const {}
};

__device__ __forceinline__ void pos_map(int wgid, int nM, int nN, int& pm, int& pn) {
    const int nig = WGM * nN, gid = wgid / nig, fm = gid * WGM, gsz = (nM - fm) < WGM ? (nM - fm) : WGM;
    pm = fm + ((wgid % nig) % gsz); pn = (wgid % nig) / gsz;
}
__device__ __forceinline__ int chunk_lo(int x, int nwg) { const int q = nwg / NXCD, r = nwg % NXCD; return x * q + (x < r ? x : r); }
struct QueueOrder {
    unsigned* ctr8; int xcc;
    int nMb, mob, Lb0;
    int nMg, mog, L0;
    int first; volatile PG8_LAS int* slots;
    __device__ __forceinline__ int skip(int x) const { return (L0 - x + NXCD - 1) / NXCD; }
    __device__ __forceinline__ int skipb(int x) const { return (Lb0 - x + NXCD - 1) / NXCD; }
    __device__ __forceinline__ int draw() const {
        const int nb = nMb * 12, ng = nMg * 24;
        for (int k = 0; k < NXCD; ++k) { const int x = (xcc + k) & (NXCD - 1);
            const int t = (int)__hip_atomic_fetch_add(ctr8 + 64 * x, 1u, __ATOMIC_RELAXED, __HIP_MEMORY_SCOPE_AGENT);
            const int cb = chunk_lo(x + 1, nb) - chunk_lo(x, nb), sb = (skipb(x) < cb) ? skipb(x) : cb;
            if (t < cb - sb) return chunk_lo(x, nb) + sb + t;
            const int tg = t - (cb - sb) + skip(x);
            if (tg < chunk_lo(x + 1, ng) - chunk_lo(x, ng)) return nb + chunk_lo(x, ng) + tg; }
        return 0x3fffffff;
    }
    __device__ __forceinline__ bool next(int i, Unit& u) const {
        int P;
        if (i == 0) P = first;
        else { P = slots[i & 3]; if (threadIdx.x == 0) slots[(i + 1) & 3] = draw(); }
        P = __builtin_amdgcn_readfirstlane(P);
        const int nb = nMb * 12;
        if (P >= nb + nMg * 24) return false;
        int pm, pn;
        if (P < nb) { pos_map(P, nMb, 12, pm, pn); u.pm = mob ? main_tile(pm) : pm; u.pn = colB(pn); }
        else { pos_map(P - nb, nMg, 24, pm, pn); u.pm = mog ? main_tile(pm) : pm; u.pn = 40 + pn; }
        return true;
    }
    __device__ __forceinline__ void a_ready(const Unit&) const {}
    __device__ __forceinline__ void done(const Unit&) const {}
};

__device__ __forceinline__ unsigned cvt_pk_bf16(float lo, float hi) { unsigned r; asm volatile("v_cvt_pk_bf16_f32 %0, %1, %2" : "=v"(r) : "v"(lo), "v"(hi)); return r; }
__device__ __forceinline__ float fast_sigmoid(float x) { return __builtin_amdgcn_rcpf(1.0f + __builtin_amdgcn_exp2f(-1.44269504f * x)); }

typedef unsigned u32x2 __attribute__((ext_vector_type(2)));
__device__ __forceinline__ u32x2* gate_img(const bf16_t* U, int pm, int pn, int wid, int slot, int lane) {
    return (u32x2*)((unsigned char*)((bf16_t*)U + (size_t)(pm * BM + 2 * (wid * 16 + slot) + (lane >> 5)) * NU + pn * BM) + (lane & 31) * 8);
}
__device__ __forceinline__ float gate_q1(float g) { return __builtin_rintf(fmaxf(g * 255.0f, 1.0f)); }
__device__ __forceinline__ unsigned gate_q4(f32x4 g) {
    unsigned r = __builtin_amdgcn_cvt_pk_u8_f32(gate_q1(g[0]), 0u, 0u); r = __builtin_amdgcn_cvt_pk_u8_f32(gate_q1(g[1]), 1u, r);
    r = __builtin_amdgcn_cvt_pk_u8_f32(gate_q1(g[2]), 2u, r); return __builtin_amdgcn_cvt_pk_u8_f32(gate_q1(g[3]), 3u, r);
}
__device__ __forceinline__ f32x4 gate_c4(unsigned w) { return (f32x4){(float)(w & 0xffu), (float)((w >> 8) & 0xffu), (float)((w >> 16) & 0xffu), (float)(w >> 24)}; }
struct EpiC {
    static constexpr bool PERM = true, AFTER_DRAIN = false, MID = false; static constexpr int MID_T1 = -1, MID_T2 = -1;
    bf16_t* U; float* US; const float* bgate; const float* sa8; float sw8;
    __device__ __forceinline__ void operator()(const f32x4 (&acc)[2][2][4][2], const Unit& u, int wr, int wc, int fr, int fq) const {
        asm volatile("" : "+v"(fr), "+v"(fq));
        const int row0 = u.pm * BM + wr * 64 + fr;
        if (u.pn < 64) {
            const bool gate = u.pn >= 40;
            const int col0 = u.pn * BM + wc * 32 + 8 * fq;
            f32x4 bv[2][2];
#pragma unroll
            for (int bj = 0; bj < 2; ++bj)
#pragma unroll
                for (int n = 0; n < 2; ++n) bv[bj][n] = gate ? *(const f32x4*)(bgate + (col0 - 40 * BM) + bj * HALF + 4 * n) : (f32x4){0.f, 0.f, 0.f, 0.f};
            float rsv[2][4];
#pragma unroll
            for (int ai = 0; ai < 2; ++ai)
#pragma unroll
                for (int m = 0; m < 4; ++m) rsv[ai][m] = gate ? sa8[row0 + ai * HALF + m * 16] : 0.f;
            asm volatile("" : "+v"(rsv[0][0]), "+v"(rsv[0][1]), "+v"(rsv[0][2]), "+v"(rsv[0][3]), "+v"(rsv[1][0]), "+v"(rsv[1][1]), "+v"(rsv[1][2]), "+v"(rsv[1][3]));
#pragma unroll
            for (int ai = 0; ai < 2; ++ai)
#pragma unroll
                for (int m = 0; m < 4; ++m) { bf16_t* rowp = U + (size_t)(row0 + ai * HALF + m * 16) * NU + col0;
                    const float rs = rsv[ai][m] * sw8;
#pragma unroll
                    for (int bj = 0; bj < 2; ++bj) { f32x4 v0 = acc[ai][bj][m][0], v1 = acc[ai][bj][m][1];
                        if (gate) { const v4i_t i0 = __builtin_bit_cast(v4i_t, v0), i1 = __builtin_bit_cast(v4i_t, v1);
                            v0 = (f32x4){(float)i0[0], (float)i0[1], (float)i0[2], (float)i0[3]} * rs + bv[bj][0]; v1 = (f32x4){(float)i1[0], (float)i1[1], (float)i1[2], (float)i1[3]} * rs + bv[bj][1]; }
                        if (gate) {
#pragma unroll
                            for (int j = 0; j < 4; ++j) { v0[j] = fast_sigmoid(v0[j]); v1[j] = fast_sigmoid(v1[j]); } }
                        if (gate) { u32x2 q; q.x = gate_q4(v0); q.y = gate_q4(v1); *gate_img(U, u.pm, u.pn, wr * 4 + wc, (ai * 4 + m) * 2 + bj, fq * 16 + fr) = q; }
                        else { u32x4 w; w.x = cvt_pk_bf16(v0[0], v0[1]); w.y = cvt_pk_bf16(v0[2], v0[3]); w.z = cvt_pk_bf16(v1[0], v1[1]); w.w = cvt_pk_bf16(v1[2], v1[3]); *(u32x4*)(rowp + bj * HALF) = w; } } }
        } else {
#pragma unroll
            for (int ai = 0; ai < 2; ++ai)
#pragma unroll
                for (int m = 0; m < 4; ++m) { float* rowp = US + (size_t)(row0 + ai * HALF + m * 16) * USL;
#pragma unroll
                    for (int n = 0; n < 2; ++n) { const int cc = wc * 32 + 8 * fq + 4 * n; if (cc < 48) *(f32x4*)(rowp + cc) = acc[ai][0][m][n]; } }
        }
    }
};

struct EpiF {
    static constexpr bool PERM = true, AFTER_DRAIN = false, MID = true; static constexpr int MID_T1 = 16, MID_T2 = 32;
    const bf16_t* U; bf16_t* MG; int skip_mid;
    __device__ __forceinline__ void mid(f32x4 (&acc)[2][2][4][2], const Unit& u, int t, int wr, int wc, int fr, int fq) const {
        const int seg = (t == MID_T1) ? 0 : 1;
        if (MK_DUP == 42 && skip_mid) return;
        asm volatile("" : "+v"(fr), "+v"(fq));
        const int row0 = u.pm * BM + wr * 64 + fr, col0 = u.pn * BM + wc * 32 + 8 * fq;
        u32x2 ga[2][4][2], gb[2][4][2];
#pragma unroll
        for (int ai = 0; ai < 2; ++ai)
#pragma unroll
            for (int m = 0; m < 4; ++m)
#pragma unroll
                for (int bj = 0; bj < 2; ++bj) { const u32x2* gp = gate_img(U, u.pm, 40 + seg * 8 + u.pn, wr * 4 + wc, (ai * 4 + m) * 2 + bj, fq * 16 + fr);
                    ga[ai][m][bj] = *gp; gb[ai][m][bj] = *(const u32x2*)((const unsigned char*)gp + 2048 * 2); }
        asm volatile("" ::: "memory");
#pragma unroll
        for (int ai = 0; ai < 2; ++ai)
#pragma unroll
            for (int m = 0; m < 4; ++m) asm volatile("" : "+v"(ga[ai][m][0]), "+v"(ga[ai][m][1]), "+v"(gb[ai][m][0]), "+v"(gb[ai][m][1]));
#pragma unroll
        for (int ai = 0; ai < 2; ++ai)
#pragma unroll
            for (int m = 0; m < 4; ++m)
#pragma unroll
                for (int bj = 0; bj < 2; ++bj) {
                    const f32x4 a0 = gate_c4(ga[ai][m][bj].x), a1 = gate_c4(ga[ai][m][bj].y), b0 = gate_c4(gb[ai][m][bj].x), b1 = gate_c4(gb[ai][m][bj].y);
                    f32x4 r0, r1;
#pragma unroll
                    for (int j = 0; j < 4; ++j) { r0[j] = a0[j] * __builtin_amdgcn_rcpf(b0[j]); r1[j] = a1[j] * __builtin_amdgcn_rcpf(b1[j]); }
                    acc[ai][bj][m][0] *= r0; acc[ai][bj][m][1] *= r1; }
        asm volatile("" ::: "memory");
    }
    __device__ __forceinline__ void operator()(const f32x4 (&acc)[2][2][4][2], const Unit& u, int wr, int wc, int fr, int fq) const {
        asm volatile("" : "+v"(fr), "+v"(fq));
        const int row0 = u.pm * BM + wr * 64 + fr, col0 = u.pn * BM + wc * 32 + 8 * fq;
        u32x2 g2[2][4][2];
#pragma unroll
        for (int ai = 0; ai < 2; ++ai)
#pragma unroll
            for (int m = 0; m < 4; ++m)
#pragma unroll
                for (int bj = 0; bj < 2; ++bj) g2[ai][m][bj] = *gate_img(U, u.pm, 56 + u.pn, wr * 4 + wc, (ai * 4 + m) * 2 + bj, fq * 16 + fr);
        asm volatile("" ::: "memory");
#pragma unroll
        for (int ai = 0; ai < 2; ++ai)
#pragma unroll
            for (int m = 0; m < 4; ++m) { const int row = row0 + ai * HALF + m * 16; bf16_t* op = MG + (size_t)row * LDK + col0;
#pragma unroll
                for (int bj = 0; bj < 2; ++bj) { const u32x2 g = g2[ai][m][bj];
                    const f32x4 v0 = acc[ai][bj][m][0] * (gate_c4(g.x) * (1.0f / 255.0f)), v1 = acc[ai][bj][m][1] * (gate_c4(g.y) * (1.0f / 255.0f));
                    u32x4 w; w.x = cvt_pk_bf16(v0[0], v0[1]); w.y = cvt_pk_bf16(v0[2], v0[3]); w.z = cvt_pk_bf16(v1[0], v1[1]); w.w = cvt_pk_bf16(v1[2], v1[3]);
                    *(u32x4*)(op + bj * HALF) = w; } }
    }
};

struct EpiG {
    static constexpr bool PERM = true, AFTER_DRAIN = false, MID = false; static constexpr int MID_T1 = -1, MID_T2 = -1;
    bf16_t* C; int ldc;
    __device__ __forceinline__ void operator()(const f32x4 (&acc)[2][2][4][2], const Unit& u, int wr, int wc, int fr, int fq) const {
        asm volatile("" : "+v"(fr), "+v"(fq));
        const int row0 = u.pm * BM + wr * 64 + fr, col0 = u.pn * BM + wc * 32 + 8 * fq;
#pragma unroll
        for (int ai = 0; ai < 2; ++ai)
#pragma unroll
            for (int m = 0; m < 4; ++m) { bf16_t* rowp = C + (size_t)(row0 + ai * HALF + m * 16) * ldc + col0;
#pragma unroll
                for (int bj = 0; bj < 2; ++bj) { const f32x4 v0 = acc[ai][bj][m][0], v1 = acc[ai][bj][m][1];
                    u32x4 w; w.x = cvt_pk_bf16(v0[0], v0[1]); w.y = cvt_pk_bf16(v0[2], v0[3]); w.z = cvt_pk_bf16(v1[0], v1[1]); w.w = cvt_pk_bf16(v1[2], v1[3]);
                    *(u32x4*)(rowp + bj * HALF) = w; } }
    }
};

template <class Epi, class Sched, bool ALIGN_EPI = false, bool SP2 = false, bool I8 = false>
__device__ __forceinline__ void gemm_phase(PG8_LAS unsigned char* lds, const Gemm g, const Sched& S, const Epi& E) {
    int tid_l = threadIdx.x; asm volatile("" : "+v"(tid_l));
    const int tid = tid_l, wid = __builtin_amdgcn_readfirstlane(tid >> 6), lane = tid & 63, wr = wid >> 2, wc = wid & 3, fr = lane & 15, fq = lane >> 4;
    const int K = g.K, nt = K / BK;
    unsigned voffA[2], voffB[2];
#pragma unroll
    for (int i = 0; i < 2; ++i) { int R, C; stage_rc(tid * 16 + i * 8192, R, C); const int Rb = Epi::PERM ? ((R & ~31) + perm32(R & 31)) : R;
        voffA[i] = (unsigned)(R * g.ld + C) * 2u; voffB[i] = (unsigned)(Rb * g.ld + C) * 2u; }
    const size_t kstep = (size_t)(BK * 2);
    const size_t hstep = (size_t)HALF * g.ld * 2;
    const size_t tstep = 2 * hstep;
    const unsigned ldsw = (unsigned)wid * 1024u;
    const int aoff = lds_byte(wr * 64 + fr, fq * 8), boff = lds_byte(wc * 32 + fr, fq * 8);
#define PG8_SA(b, h) (((b) * 2 + (h)) * HTB)
#define PG8_SB(b, h) ((4 + (b) * 2 + (h)) * HTB)
#define PG8_STAGE(bufoff, gbase, voff) do { _Pragma("unroll") for (int _i = 0; _i < 2; ++_i) \
        __builtin_amdgcn_global_load_lds((const unsigned*)((const char*)(gbase) + (voff)[_i]), (PG8_LAS unsigned*)(lds + (bufoff) + ldsw + _i * 8192), 16, 0, 0); } while (0)
#define PG8_LDA(dst, b, h) do { _Pragma("unroll") for (int m = 0; m < 4; ++m) _Pragma("unroll") for (int k = 0; k < 2; ++k) dst[m][k] = *(const PG8_LAS bf16x8*)(lds + PG8_SA(b, h) + aoff + m * 2048 + k * 1024); } while (0)
#define PG8_LDB(dst, b, h) do { _Pragma("unroll") for (int n = 0; n < 2; ++n) _Pragma("unroll") for (int k = 0; k < 2; ++k) dst[n][k] = *(const PG8_LAS bf16x8*)(lds + PG8_SB(b, h) + boff + n * 2048 + k * 1024); } while (0)
#define PG8_MMA(ai, bj, At, Bt) do { __builtin_amdgcn_s_setprio(1); _Pragma("unroll") for (int m = 0; m < 4; ++m) _Pragma("unroll") for (int n = 0; n < 2; ++n) _Pragma("unroll") for (int k = 0; k < 2; ++k) { \
        if constexpr (I8) acc[ai][bj][m][n] = __builtin_bit_cast(f32x4, __builtin_amdgcn_mfma_i32_16x16x64_i8(__builtin_bit_cast(v4i_t, Bt[n][k]), __builtin_bit_cast(v4i_t, At[m][k]), __builtin_bit_cast(v4i_t, acc[ai][bj][m][n]), 0, 0, 0)); \
        else acc[ai][bj][m][n] = __builtin_amdgcn_mfma_f32_16x16x32_bf16(Bt[n][k], At[m][k], acc[ai][bj][m][n], 0, 0, 0); } __builtin_amdgcn_s_setprio(0); } while (0)
#define PG8_WAIT_V(n) asm volatile("s_waitcnt vmcnt(" #n ")" ::: "memory")
#define PG8_WAIT_L(n) asm volatile("s_waitcnt lgkmcnt(" #n ")" ::: "memory")
#define PG8_BAR __builtin_amdgcn_s_barrier()
#define PG8_SCHED __builtin_amdgcn_sched_barrier(0)
    Unit cur, nxt; int ui = 0;
    if (!S.next(0, cur)) return;
    f32x4 acc[2][2][4][2];
#pragma unroll
    for (int a = 0; a < 2; ++a)
#pragma unroll
        for (int b = 0; b < 2; ++b)
#pragma unroll
            for (int m = 0; m < 4; ++m)
#pragma unroll
                for (int n = 0; n < 2; ++n) acc[a][b][m][n] = (f32x4){0.f, 0.f, 0.f, 0.f};
    bf16x8 At[4][2], B0[2][2], B1[2][2];
    const char* cA = (const char*)g.A + (size_t)cur.pm * tstep; const char* cB = (const char*)g.Bt + (size_t)cur.pn * tstep;
    S.a_ready(cur);
    if constexpr (SP2) {
        PG8_STAGE(PG8_SB(0, 0), cB, voffB); PG8_STAGE(PG8_SB(0, 1), cB + hstep, voffB); PG8_STAGE(PG8_SA(0, 0), cA, voffA); PG8_STAGE(PG8_SA(0, 1), cA + hstep, voffA);
        if (wr == 1) PG8_BAR;
        PG8_WAIT_V(2); PG8_BAR;
        PG8_STAGE(PG8_SB(1, 0), cB + kstep, voffB); PG8_STAGE(PG8_SA(1, 0), cA + kstep, voffA); PG8_STAGE(PG8_SB(1, 1), cB + hstep + kstep, voffB);
        PG8_WAIT_V(6); PG8_BAR;
    } else {
        PG8_STAGE(PG8_SB(0, 0), cB, voffB); PG8_STAGE(PG8_SA(0, 0), cA, voffA); PG8_STAGE(PG8_SB(0, 1), cB + hstep, voffB); PG8_STAGE(PG8_SA(0, 1), cA + hstep, voffA);
        if (wr == 1) PG8_BAR;
        PG8_WAIT_V(4); PG8_BAR;
        PG8_STAGE(PG8_SB(1, 0), cB + kstep, voffB); PG8_STAGE(PG8_SA(1, 0), cA + kstep, voffA); PG8_STAGE(PG8_SB(1, 1), cB + hstep + kstep, voffB);
        PG8_WAIT_V(6); PG8_BAR;
    }
    for (;;) {
        const bool has_next = S.next(ui + 1, nxt);
        const char* nA = has_next ? (const char*)g.A + (size_t)nxt.pm * tstep : cA; const char* nB = has_next ? (const char*)g.Bt + (size_t)nxt.pn * tstep : cB;
        const int tseg = Epi::MID ? Epi::MID_T1 : nt;
        for (int tb = 0; tb < nt; tb += tseg) {
        if constexpr (Epi::MID) { if (tb != 0) E.mid(acc, cur, tb, wr, wc, fr, fq); }
        for (int t = tb; t < tb + tseg; t += 2) {
            const bool last = (t == nt - 2);
            const char* a1 = cA + (size_t)(t + 1) * kstep;
            const char* a2 = last ? nA : cA + (size_t)(t + 2) * kstep; const char* b2 = last ? nB : cB + (size_t)(t + 2) * kstep;
            const char* a3 = a2 + kstep; const char* b3 = b2 + kstep;
            if (last && has_next) S.a_ready(nxt);

            if constexpr (SP2) {
            PG8_LDB(B0, 0, 0); PG8_LDB(B1, 0, 1); PG8_SCHED; PG8_LDA(At, 0, 0); PG8_STAGE(PG8_SA(1, 1), a1 + hstep, voffA);
            PG8_WAIT_V(8); PG8_WAIT_L(0); PG8_BAR; PG8_MMA(0, 0, At, B0); PG8_MMA(0, 1, At, B1); PG8_BAR; PG8_SCHED;
            PG8_LDA(At, 0, 1); PG8_STAGE(PG8_SB(0, 0), b2, voffB); PG8_STAGE(PG8_SB(0, 1), b2 + hstep, voffB); PG8_STAGE(PG8_SA(0, 0), a2, voffA);
            PG8_WAIT_V(8); PG8_WAIT_L(0); PG8_BAR; PG8_MMA(1, 0, At, B0); PG8_MMA(1, 1, At, B1); PG8_BAR; PG8_SCHED;
            PG8_LDB(B0, 1, 0); PG8_LDB(B1, 1, 1); PG8_SCHED; PG8_LDA(At, 1, 0); PG8_STAGE(PG8_SA(0, 1), a2 + hstep, voffA);
            PG8_WAIT_V(8); PG8_WAIT_L(0); PG8_BAR; PG8_MMA(0, 0, At, B0); PG8_MMA(0, 1, At, B1); PG8_BAR; PG8_SCHED;
            PG8_LDA(At, 1, 1); PG8_STAGE(PG8_SB(1, 0), b3, voffB); PG8_STAGE(PG8_SB(1, 1), b3 + hstep, voffB); PG8_STAGE(PG8_SA(1, 0), a3, voffA);
            PG8_WAIT_V(8); PG8_WAIT_L(0); PG8_BAR; PG8_MMA(1, 0, At, B0); PG8_MMA(1, 1, At, B1); PG8_BAR; PG8_SCHED;
            } else {
            PG8_LDB(B0, 0, 0); PG8_SCHED; PG8_LDA(At, 0, 0); PG8_STAGE(PG8_SA(1, 1), a1 + hstep, voffA);
            PG8_WAIT_L(8); PG8_BAR; PG8_WAIT_L(0); PG8_MMA(0, 0, At, B0); PG8_BAR; PG8_SCHED;
            PG8_LDB(B1, 0, 1); PG8_STAGE(PG8_SB(0, 0), b2, voffB);
            PG8_BAR; PG8_WAIT_L(0); PG8_MMA(0, 1, At, B1); PG8_BAR;
            PG8_LDA(At, 0, 1); PG8_STAGE(PG8_SA(0, 0), a2, voffA);
            PG8_BAR; PG8_WAIT_L(0); PG8_MMA(1, 0, At, B0); PG8_BAR; PG8_SCHED;
            PG8_STAGE(PG8_SB(0, 1), b2 + hstep, voffB);
            PG8_WAIT_V(6); PG8_BAR; PG8_MMA(1, 1, At, B1); PG8_BAR;
            PG8_LDB(B0, 1, 0); PG8_SCHED; PG8_LDA(At, 1, 0); PG8_STAGE(PG8_SA(0, 1), a2 + hstep, voffA);
            PG8_WAIT_L(8); PG8_BAR; PG8_WAIT_L(0); PG8_MMA(0, 0, At, B0); PG8_BAR; PG8_SCHED;
            PG8_LDB(B1, 1, 1); PG8_STAGE(PG8_SB(1, 0), b3, voffB);
            PG8_BAR; PG8_WAIT_L(0); PG8_MMA(0, 1, At, B1); PG8_BAR;
            PG8_LDA(At, 1, 1); PG8_STAGE(PG8_SA(1, 0), a3, voffA);
            PG8_BAR; PG8_WAIT_L(0); PG8_MMA(1, 0, At, B0); PG8_BAR; PG8_SCHED;
            PG8_STAGE(PG8_SB(1, 1), b3 + hstep, voffB);
            PG8_WAIT_V(6); PG8_BAR; PG8_MMA(1, 1, At, B1); PG8_BAR;
            }
        }
        }
        if constexpr (ALIGN_EPI) { if (wr == 0) PG8_BAR; }
        if constexpr (!Epi::AFTER_DRAIN) { E(acc, cur, wr, wc, fr, fq); S.done(cur); }
        if (!has_next) break;
#pragma unroll
        for (int a = 0; a < 2; ++a)
#pragma unroll
            for (int b = 0; b < 2; ++b)
#pragma unroll
                for (int m = 0; m < 4; ++m)
#pragma unroll
                    for (int n = 0; n < 2; ++n) acc[a][b][m][n] = (f32x4){0.f, 0.f, 0.f, 0.f};
        cur = nxt; cA = nA; cB = nB; ++ui;
        if constexpr (ALIGN_EPI) { if (wr == 1) PG8_BAR; }
    }
    PG8_WAIT_V(0);
    if constexpr (!ALIGN_EPI) { if (wr == 0) PG8_BAR; }
    PG8_BAR;
    if constexpr (Epi::AFTER_DRAIN) { E.fused(acc, cur, wr, wc, fr, fq, lds, wid, lane); S.done(cur); }
#undef PG8_SA
#undef PG8_SB
#undef PG8_STAGE
#undef PG8_LDA
#undef PG8_LDB
#undef PG8_MMA
#undef PG8_WAIT_V
#undef PG8_WAIT_L
#undef PG8_BAR
#undef PG8_SCHED
}
}

#define LDS_WAIT() asm volatile("s_waitcnt lgkmcnt(0)" ::: "memory")

__device__ __forceinline__ bool w1_src(KArgs& a, int l, int d, const float*& W, int& ldw, int& col) {
    const float* win = a.in[7] + (size_t)l * 2048 * NIN; const float* wg = a.in[8] + (size_t)l * 2048 * 6144;
    if (d < 7680) { W = win; ldw = NIN; col = d; return true; }
    if (d < 9216) { W = win; ldw = NIN; col = d + 16; return true; }
    if (d < 10240) { W = win; ldw = NIN; col = 9264 + (d - 9216); return true; }
    if (d < 16384) { W = wg; ldw = 6144; col = d - 10240; return true; }
    if (d < 16400) { W = win; ldw = NIN; col = 7680 + (d - 16384); return true; }
    if (d < 16432) { W = win; ldw = NIN; col = 9232 + (d - 16400); return true; }
    W = win; ldw = NIN; col = 0; return false;
}
__device__ __forceinline__ void p0_transpose_item(const float* Wc, int ldw, bool valid, int k0, bf16* dst, int dst_ld, int drow0, int dcol0, LAS float* scr, int lane, bool f8 = false, float qscale = 0.f) {
    f32x4 wv[8];
#pragma unroll
    for (int i = 0; i < 8; ++i) { const int kk = (lane >> 3) + 8 * i; wv[i] = valid ? *(const f32x4*)(Wc + (size_t)(k0 + kk) * ldw) : (f32x4){0.f, 0.f, 0.f, 0.f}; }
#pragma unroll
    for (int i = 0; i < 8; ++i) { const int kk = (lane >> 3) + 8 * i; LAS float* pw = scr + kk * 33 + 4 * (lane & 7); pw[0] = wv[i].x; pw[1] = wv[i].y; pw[2] = wv[i].z; pw[3] = wv[i].w; }
    LDS_WAIT(); asm volatile("" ::: "memory");
    const int c = lane & 7;
#pragma unroll
    for (int j = 0; j < 4; ++j) { const int n = (lane >> 3) + 8 * j; const LAS float* s = scr + (8 * c) * 33 + n;
        if (f8) { unsigned r0 = __builtin_amdgcn_cvt_pk_u8_f32(__builtin_rintf(s[0 * 33] * qscale + 128.0f), 0u, 0u); r0 = __builtin_amdgcn_cvt_pk_u8_f32(__builtin_rintf(s[1 * 33] * qscale + 128.0f), 1u, r0);
            r0 = __builtin_amdgcn_cvt_pk_u8_f32(__builtin_rintf(s[2 * 33] * qscale + 128.0f), 2u, r0); r0 = __builtin_amdgcn_cvt_pk_u8_f32(__builtin_rintf(s[3 * 33] * qscale + 128.0f), 3u, r0);
            unsigned r1 = __builtin_amdgcn_cvt_pk_u8_f32(__builtin_rintf(s[4 * 33] * qscale + 128.0f), 0u, 0u); r1 = __builtin_amdgcn_cvt_pk_u8_f32(__builtin_rintf(s[5 * 33] * qscale + 128.0f), 1u, r1);
            r1 = __builtin_amdgcn_cvt_pk_u8_f32(__builtin_rintf(s[6 * 33] * qscale + 128.0f), 2u, r1); r1 = __builtin_amdgcn_cvt_pk_u8_f32(__builtin_rintf(s[7 * 33] * qscale + 128.0f), 3u, r1);
            v2u o8; o8.x = r0 ^ 0x80808080u; o8.y = r1 ^ 0x80808080u; *(v2u*)((unsigned char*)dst + (size_t)(drow0 + n) * dst_ld + dcol0 + k0 + 8 * c) = o8; }
        else { v4u o; o.x = pk2(s[0 * 33], s[1 * 33]); o.y = pk2(s[2 * 33], s[3 * 33]); o.z = pk2(s[4 * 33], s[5 * 33]); o.w = pk2(s[6 * 33], s[7 * 33]);
            *(v4u*)(dst + (size_t)(drow0 + n) * dst_ld + dcol0 + k0 + 8 * c) = o; } }
    LDS_WAIT(); asm volatile("" ::: "memory");
}
__device__ __forceinline__ void p0_weights(KArgs& a, int l, LAS unsigned char* lds, int lane, int wave, int gw, int NGW) {
    LAS float* scr = (LAS float*)(lds + wave * 16384);
    constexpr int I_1 = 32 * 520, I_B = 3 * 16 * 64, I_O = 32 * 64, I_L = I_1 + I_B + I_O;
    for (int it = gw; it < I_L; it += NGW) {
        int r = it;
        if (r < I_1) { const int nb = r % 520, kb = r / 520; const float* W; int ldw, col; const bool ok = w1_src(a, l, nb * 32 + 4 * (lane & 7), W, ldw, col);
            if (nb >= 320 && nb < 512) continue;
            p0_transpose_item(W + col, ldw, ok, kb * 64, (bf16*)(a.ws + WS_W1T) + (size_t)l * N1 * LDK, LDK, nb * 32, 0, scr, lane);
            continue; }
        r -= I_1;
        if (r < I_B) { const int br = r / 1024, q = r % 1024, nb = q % 64, kb = q / 64; const float* W = a.in[19] + ((size_t)(l * 3 + br) * 1024) * 2048;
            p0_transpose_item(W + nb * 32 + 4 * (lane & 7), 2048, true, kb * 64, (bf16*)(a.ws + WS_WBT) + (size_t)l * 2048 * LDK3, LDK3, nb * 32, br * 1024, scr, lane); continue; }
        r -= I_B;
        { const int nb = r % 64, kb = r / 64; const float* W = a.in[20] + (size_t)l * 2048 * 2048;
            p0_transpose_item(W + nb * 32 + 4 * (lane & 7), 2048, true, kb * 64, (bf16*)(a.ws + WS_WOT) + (size_t)l * 2048 * LDK, LDK, nb * 32, 0, scr, lane); }
    }
}
__device__ __forceinline__ void p0_gate_absmax(KArgs& a, int lane, int gw, int NGW) {
    for (int l = 0; l < 2; ++l) { const f32x4* W = (const f32x4*)(a.in[8] + (size_t)l * 2048 * 6144); float m = 0.f;
        for (int i = gw * 64 + lane; i < 2048 * 6144 / 4; i += NGW * 64 * 4) {
            f32x4 t[4];
#pragma unroll
            for (int j = 0; j < 4; ++j) { const int ii = i + j * NGW * 64; t[j] = (ii < 2048 * 6144 / 4) ? W[ii] : (f32x4){0.f, 0.f, 0.f, 0.f}; }
#pragma unroll
            for (int j = 0; j < 4; ++j) m = fmaxf(m, fmaxf(fmaxf(fabsf(t[j].x), fabsf(t[j].y)), fmaxf(fabsf(t[j].z), fabsf(t[j].w)))); }
        m = wave_max(m);
        if (lane == 0) (void)__hip_atomic_fetch_max((unsigned*)(a.ws + WS_CTL) + CW_WMAX + l, __builtin_bit_cast(unsigned, m), __ATOMIC_RELAXED, __HIP_MEMORY_SCOPE_AGENT); }
}
__device__ __forceinline__ void p0_gate_weights(KArgs& a, int l, LAS unsigned char* lds, int lane, int wave, int gw, int NGW) {
    LAS float* scr = (LAS float*)(lds + wave * 16384);
    const float wmax = __builtin_bit_cast(float, __hip_atomic_load((unsigned*)(a.ws + WS_CTL) + CW_WMAX + l, __ATOMIC_RELAXED, __HIP_MEMORY_SCOPE_AGENT));
    const float qs = (wmax > 0.f) ? 127.0f / wmax : 0.f;
    const float* W = a.in[8] + (size_t)l * 2048 * 6144;
    for (int it = gw; it < 32 * 192; it += NGW) { const int nb = it % 192, kb = it / 192;
        p0_transpose_item(W + nb * 32 + 4 * (lane & 7), 6144, true, kb * 64, (bf16*)(a.ws + WS_WG8 + (size_t)l * 6144 * LD8), LD8, nb * 32, 0, scr, lane, true, qs); }
}
__device__ __forceinline__ void phase_p0(KArgs& a, LAS unsigned char* lds, int tid, int lane, int wave, int G, int c) {
    {
        LAS float* sc = (LAS float*)lds;
        LAS float* red = sc + 17 * 1024;
        for (int u = c; u < 192; u += G) {
            const int l = u / 96, col0 = (u % 96) * 64, col = tid & 63, kg = tid >> 6;
            const float* W = a.in[4] + (size_t)l * 2048 * 6144;
            float acc[17];
#pragma unroll
            for (int b = 0; b < 17; ++b) acc[b] = 0.f;
            for (int kh = 0; kh < 2; ++kh) {
                __syncthreads();
                { float cv[34];
#pragma unroll
                  for (int j = 0; j < 34; ++j) { const int i = tid + 512 * j, b = i >> 10, k = kh * 1024 + (i & 1023); cv[j] = (b < 16) ? a.in[1][b * 2048 + k] : a.in[3][k]; }
#pragma unroll
                  for (int j = 0; j < 34; ++j) sc[tid + 512 * j] = silu_f(cv[j]); }
                __syncthreads();
                for (int k8 = 0; k8 < 128; k8 += 16) { float w[16];
#pragma unroll
                    for (int j = 0; j < 16; ++j) w[j] = W[(size_t)(kh * 1024 + kg * 128 + k8 + j) * 6144 + col0 + col];
#pragma unroll
                    for (int j = 0; j < 16; ++j) { const int kl = kg * 128 + k8 + j;
#pragma unroll
                        for (int b = 0; b < 17; ++b) acc[b] += sc[b * 1024 + kl] * w[j]; } }
            }
#pragma unroll
            for (int b = 0; b < 17; ++b) red[(kg * 17 + b) * 64 + col] = acc[b];
            __syncthreads();
            float* MOD = (float*)(a.ws + WS_MOD) + (size_t)l * 17 * 6144;
            for (int i = tid; i < 17 * 64; i += 512) { const int b = i >> 6, cc = i & 63; float s = a.in[5][l * 6144 + col0 + cc];
#pragma unroll
                for (int g = 0; g < 8; ++g) s += red[(g * 17 + b) * 64 + cc];
                const int jm = col0 + cc;
                if (jm >= 4096) s *= a.in[21][l * 2048 + jm - 4096]; else if (jm >= 2048) s = a.in[6][l * 2048 + jm - 2048] * (s + 1.0f);
                MOD[b * 6144 + jm] = s; }
        }
        __syncthreads();
    }
    const int gw = c * 8 + wave, NGW = G * 8;
    {
        float* rc = (float*)(a.ws + WS_ROPE); float* rs = rc + 2048 * 64;
        for (int i = gw * 64 + lane; i < 2048 * 64; i += NGW * 64) { const int t = i >> 6, p = i & 63; const float inv = powf(10000.0f, -(float)(p & 31) / 32.0f);
            const float ang = (float)((p < 32) ? (t >> 6) : (t & 63)) * inv; rc[i] = cosf(ang); rs[i] = sinf(ang); }
    }
    p0_gate_absmax(a, lane, gw, NGW);
    p0_weights(a, 0, lds, lane, wave, gw, NGW);
}

#define COLK(k_) (512 * ((k_) >> 1) + 8 * lane + 4 * ((k_) & 1))
__device__ __forceinline__ void stage_mod(LAS float* dst, const float* mod_l, int part, int pass, int tid) {
    const int k = tid >> 6, ln = tid & 63, col = 512 * (k >> 1) + 8 * ln + 4 * (k & 1);
    f32x4 t[5];
#pragma unroll
    for (int r5 = 0; r5 < 5; ++r5) { const int mrow = (r5 == 4) ? 16 : pass * NBP + r5; t[r5] = *(const f32x4*)(mod_l + (size_t)mrow * 6144 + part * 2048 + col); }
#pragma unroll
    for (int r5 = 0; r5 < 5; ++r5) *(LAS f32x4*)(dst + (size_t)(tid + 512 * r5) * 4) = t[r5];
}
#define MODV(base_, r5_, k_) (*(const LAS f32x4*)((base_) + (size_t)((((r5_) * 8 + (k_)) * 64 + lane) * 4)))
__device__ __forceinline__ void norm_mod_store(const f32x4 (&v)[8], const LAS float* SH, const LAS float* SC, int r5, bf16* dst, unsigned char* dst8, float* sa_row, int lane) {
    float ss = 0.f;
#pragma unroll
    for (int k = 0; k < 8; ++k) ss += (v[k].x * v[k].x + v[k].y * v[k].y) + (v[k].z * v[k].z + v[k].w * v[k].w);
    ss = wave_sum(ss);
    const float rstd = 1.0f / sqrtf(ss * (1.0f / 2048.0f) + EPS);
    v4u w[4]; f32x4 o[8]; float mx = 0.f;
#pragma unroll
    for (int k = 0; k < 8; ++k) { o[k] = (v[k] * rstd) * MODV(SC, r5, k) + MODV(SH, r5, k);
        mx = fmaxf(mx, fmaxf(fmaxf(fabsf(o[k].x), fabsf(o[k].y)), fmaxf(fabsf(o[k].z), fabsf(o[k].w)))); }
#pragma unroll
    for (int j = 0; j < 4; ++j) { w[j].x = pk2(o[2 * j].x, o[2 * j].y); w[j].y = pk2(o[2 * j].z, o[2 * j].w); w[j].z = pk2(o[2 * j + 1].x, o[2 * j + 1].y); w[j].w = pk2(o[2 * j + 1].z, o[2 * j + 1].w); }
    mx = wave_max(mx);
    const float qs = (mx > 0.f) ? 127.0f / mx : 0.f;
    if (lane == 0) *sa_row = mx * (1.0f / 127.0f);
#pragma unroll
    for (int j = 0; j < 4; ++j) { *(v4u*)(dst + COLK(2 * j)) = w[j];
        v2u q8;
        { const f32x4 t = o[2 * j] * qs + 128.0f; unsigned r = __builtin_amdgcn_cvt_pk_u8_f32(__builtin_rintf(t.x), 0u, 0u); r = __builtin_amdgcn_cvt_pk_u8_f32(__builtin_rintf(t.y), 1u, r); r = __builtin_amdgcn_cvt_pk_u8_f32(__builtin_rintf(t.z), 2u, r); q8.x = __builtin_amdgcn_cvt_pk_u8_f32(__builtin_rintf(t.w), 3u, r) ^ 0x80808080u; }
        { const f32x4 t = o[2 * j + 1] * qs + 128.0f; unsigned r = __builtin_amdgcn_cvt_pk_u8_f32(__builtin_rintf(t.x), 0u, 0u); r = __builtin_amdgcn_cvt_pk_u8_f32(__builtin_rintf(t.y), 1u, r); r = __builtin_amdgcn_cvt_pk_u8_f32(__builtin_rintf(t.z), 2u, r); q8.y = __builtin_amdgcn_cvt_pk_u8_f32(__builtin_rintf(t.w), 3u, r) ^ 0x80808080u; }
        *(v2u*)(dst8 + COLK(2 * j)) = q8; }
}
__device__ __forceinline__ void phase_B(KArgs& a, int pass, LAS unsigned char* lds, int lane, int gw, int NGW) {
    LAS float* SH = (LAS float*)lds; LAS float* SC = SH + 5 * 2048;
    { const int tid = (gw & 7) * 64 + lane; const float* MOD0 = (const float*)(a.ws + WS_MOD); __syncthreads(); stage_mod(SH, MOD0, 0, pass, tid); stage_mod(SC, MOD0, 1, pass, tid); __syncthreads(); }
#define B_SRC(rl_) ((((rl_) % RB) < CTXL) ? a.in[2] + ((size_t)(pass * NBP + (rl_) / RB) * CTXL + ((rl_) % RB)) * 2048 : a.in[0] + ((size_t)(pass * NBP + (rl_) / RB) * SEQ + (((rl_) % RB) - CTXL)) * 2048)
    for (int rl = gw; rl < RP; rl += 2 * NGW) {
        const int rl2 = rl + NGW; const bool two = rl2 < RP;
        const float* s0 = B_SRC(rl); const float* s1 = two ? B_SRC(rl2) : s0;
        f32x4 v[8], v2[8];
#pragma unroll
        for (int k = 0; k < 8; ++k) v[k] = *(const f32x4*)(s0 + COLK(k));
        if (two) {
#pragma unroll
            for (int k = 0; k < 8; ++k) v2[k] = *(const f32x4*)(s1 + COLK(k)); }
        norm_mod_store(v, SH, SC, ((rl % RB) < CTXL) ? 4 : rl / RB, (bf16*)(a.ws + ws_hb(pass)) + (size_t)rl * LDK, a.ws + ws_hb8(pass) + (size_t)rl * LD8, (float*)(a.ws + ws_sa8(pass)) + rl, lane);
        if (two) norm_mod_store(v2, SH, SC, ((rl2 % RB) < CTXL) ? 4 : rl2 / RB, (bf16*)(a.ws + ws_hb(pass)) + (size_t)rl2 * LDK, a.ws + ws_hb8(pass) + (size_t)rl2 * LD8, (float*)(a.ws + ws_sa8(pass)) + rl2, lane);
    }
#undef B_SRC
    __syncthreads();
}
__device__ __forceinline__ void phase_H(KArgs& a, int pass, int l, LAS unsigned char* lds, int lane, int gw, int NGW) {
    LAS float* GT = (LAS float*)lds; LAS float* SH = GT + 5 * 2048; LAS float* SC = SH + 5 * 2048;
    { const int tid = (gw & 7) * 64 + lane; const float* MODl = (const float*)(a.ws + WS_MOD) + (size_t)l * 17 * 6144; __syncthreads(); stage_mod(GT, MODl, 2, pass, tid);
      if (l == 0) { stage_mod(SH, MODl + 17 * 6144, 0, pass, tid); stage_mod(SC, MODl + 17 * 6144, 1, pass, tid); } __syncthreads(); }
    const bf16* Y = (const bf16*)(a.ws + WS_Y);
    const int nrows = (l == 0) ? RP : NBP * SEQ;
#define H_ROW(i_) ((l == 0) ? (i_) : (((i_) / SEQ) * RB + CTXL + ((i_) % SEQ)))
#define H_SRC(rl_, xo_) do { const int b_ = pass * NBP + (rl_) / RB, j_ = (rl_) % RB; \
        xo_ = (l == 0) ? ((j_ < CTXL) ? a.in[2] + ((size_t)b_ * CTXL + j_) * 2048 : a.in[0] + ((size_t)b_ * SEQ + (j_ - CTXL)) * 2048) : a.out + ((size_t)b_ * SEQ + (j_ - CTXL)) * 2048; } while (0)
    v4u ywn[4]; f32x4 xnn[8];
    if (gw < nrows) { const int rl = H_ROW(gw); const float* xo; H_SRC(rl, xo); const bf16* yr = Y + (size_t)rl * 2048;
#pragma unroll
        for (int j = 0; j < 4; ++j) ywn[j] = *(const v4u*)(yr + COLK(2 * j));
#pragma unroll
        for (int k = 0; k < 8; ++k) xnn[k] = *(const f32x4*)(xo + COLK(k)); }
    for (int i = gw; i < nrows; i += NGW) {
        const int rl = H_ROW(i), b = pass * NBP + rl / RB, j = rl % RB; const bool is_ctx = j < CTXL;
        float* orow = a.out + ((size_t)b * SEQ + (is_ctx ? 0 : (j - CTXL))) * 2048;
        const int r5 = is_ctx ? 4 : rl / RB;
        f32x4 y[8], xn[8]; v4u yw[4]; float ss = 0.f;
#pragma unroll
        for (int jj = 0; jj < 4; ++jj) yw[jj] = ywn[jj];
#pragma unroll
        for (int k = 0; k < 8; ++k) xn[k] = xnn[k];
        if (i + NGW < nrows) { const int rl2 = H_ROW(i + NGW); const float* xo2; H_SRC(rl2, xo2); const bf16* yr2 = Y + (size_t)rl2 * 2048;
#pragma unroll
            for (int jj = 0; jj < 4; ++jj) ywn[jj] = *(const v4u*)(yr2 + COLK(2 * jj));
#pragma unroll
            for (int k = 0; k < 8; ++k) xnn[k] = *(const f32x4*)(xo2 + COLK(k)); }
#pragma unroll
        for (int jj = 0; jj < 4; ++jj) { y[2 * jj] = (f32x4){bflo(yw[jj].x), bfhi(yw[jj].x), bflo(yw[jj].y), bfhi(yw[jj].y)}; y[2 * jj + 1] = (f32x4){bflo(yw[jj].z), bfhi(yw[jj].z), bflo(yw[jj].w), bfhi(yw[jj].w)}; }
#pragma unroll
        for (int k = 0; k < 8; ++k) ss += (y[k].x * y[k].x + y[k].y * y[k].y) + (y[k].z * y[k].z + y[k].w * y[k].w);
        ss = wave_sum(ss);
        const float rstd = 1.0f / sqrtf(ss * (1.0f / 2048.0f) + EPS);
#pragma unroll
        for (int k = 0; k < 8; ++k) xn[k] = xn[k] + MODV(GT, r5, k) * (y[k] * rstd);
        if (!is_ctx) {
#pragma unroll
            for (int k = 0; k < 8; ++k) *(f32x4*)(orow + COLK(k)) = xn[k]; }
        if (l == 0) norm_mod_store(xn, SH, SC, r5, (bf16*)(a.ws + ws_hb(pass)) + (size_t)rl * LDK, a.ws + ws_hb8(pass) + (size_t)rl * LD8, (float*)(a.ws + ws_sa8(pass)) + rl, lane);
    }
#undef H_ROW
#undef H_SRC
    __syncthreads();
}

__device__ __forceinline__ int scan_row(int step, int dir) {
    if (dir == 0) return step;
    return step < CTXL ? (CTXL - 1 - step) : (RB - 1 - (step - CTXL));
}
__device__ __forceinline__ void mlstm_simple_unit(KArgs& a, int l, int unit, LAS unsigned char* ldsb, int tid) {
    const int es = unit & 3, dir = (unit >> 2) & 1, head = (unit >> 3) & 3, bl = unit >> 5;
    const int lane = tid & 63, dg = tid >> 6, e = lane;
    LAS float* qs = (LAS float*)ldsb; LAS float* ks = qs + 256; LAS float* vs = ks + 256; LAS float* part = vs + 64; LAS float* qnp = part + 512;
    const bf16* U = (const bf16*)(a.ws + WS_U) + (size_t)bl * RB * NU;
    const float* US = (const float*)(a.ws + WS_US) + (size_t)bl * RB * USL;
    float* H = (float*)(a.ws + WS_SC) + (size_t)dir * RP * 1024 + (size_t)bl * RB * 1024;
    const float gbi = a.in[11][l * 16 + (dir * 2) * 4 + head], gbf = a.in[11][l * 16 + (dir * 2 + 1) * 4 + head];
    float C[32];
#pragma unroll
    for (int i = 0; i < 32; ++i) C[i] = 0.f;
    float nn = 0.f, m = 0.f, pq = 0.f, pk = 0.f, pv = 0.f, pgi = 0.f, pgf = 0.f;
    int j = scan_row(0, dir);
#define ML_LOAD(jj) do { const bf16* ur = U + (size_t)(jj) * NU; if (tid < 256) { pq = bf2f(ur[UMQ + head * 256 + tid]); pk = bf2f(ur[UMK + head * 256 + tid]) * 0.0625f; } \
        else if (tid < 320) pv = bf2f(ur[UMV + head * 256 + es * 64 + tid - 256]); \
        pgi = US[(size_t)(jj) * USL + (dir * 2) * 4 + head]; pgf = US[(size_t)(jj) * USL + (dir * 2 + 1) * 4 + head]; } while (0)
    ML_LOAD(j);
    for (int step = 0; step < RB; ++step) {
        if (tid < 256) { qs[tid] = pq; ks[tid] = pk; } else if (tid < 320) vs[tid - 256] = pv;
        const float gi = pgi + gbi, lf = logsigmoid_f(pgf + gbf);
        const int jcur = j;
        if (step + 1 < RB) { j = scan_row(step + 1, dir); ML_LOAD(j); }
        const float mn = fmaxf(lf + m, gi), fs = expf(lf + m - mn), is = expf(gi - mn); m = mn;
        __syncthreads();
        const float vv = vs[e] * is; float p = 0.f;
#pragma unroll
        for (int i = 0; i < 32; ++i) { const int d = dg * 32 + i; C[i] = fs * C[i] + ks[d] * vv; p += qs[d] * C[i]; }
        part[dg * 64 + e] = p;
        if (tid < 256) { nn = fs * nn + is * ks[tid]; const float t = wave_sum(qs[tid] * nn); if (lane == 0) qnp[dg] = t; }
        __syncthreads();
        if (tid < 64) { float num = 0.f;
#pragma unroll
            for (int g = 0; g < 8; ++g) num += part[g * 64 + tid];
            const float qn = (qnp[0] + qnp[1]) + (qnp[2] + qnp[3]); const float den = fmaxf(fabsf(qn), expf(-m));
            H[(size_t)jcur * 1024 + head * 256 + es * 64 + tid] = num / den; }
    }
#undef ML_LOAD
}
__device__ __forceinline__ void ssd_simple_unit(KArgs& a, int l, int unit, LAS unsigned char* ldsb, int tid) {
    const int head = unit & 15, dir = (unit >> 4) & 1, bl = unit >> 5, grp = head >> 3;
    const int lane = tid & 63, ng = tid >> 6, p = lane;
    LAS float* xs = (LAS float*)ldsb; LAS float* Bs = xs + 64; LAS float* Cs = Bs + 128; LAS float* part = Cs + 128;
    const bf16* U = (const bf16*)(a.ws + WS_U) + (size_t)bl * RB * NU;
    const float* US = (const float*)(a.ws + WS_US) + (size_t)bl * RB * USL;
    float* Yo = (float*)(a.ws + WS_SC) + (size_t)(2 + dir) * RP * 1024 + (size_t)bl * RB * 1024;
    const float dtb = a.in[15][l * 32 + dir * 16 + head], av = -expf(a.in[16][l * 32 + dir * 16 + head]);
    int ch = -1;
    if (tid < 64) ch = head * 64 + tid; else if (tid < 192) ch = 1024 + grp * 128 + (tid - 64); else if (tid < 320) ch = 1280 + grp * 128 + (tid - 192);
    float cw[5], cb = 0.f;
#pragma unroll
    for (int tp = 0; tp < 5; ++tp) cw[tp] = (ch >= 0) ? a.in[13][(size_t)(l * 5 + tp) * 1536 + ch] : 0.f;
    if (ch >= 0) cb = a.in[14][l * 1536 + ch];
    float h[16];
#pragma unroll
    for (int i = 0; i < 16; ++i) h[i] = 0.f;
    float pre[5], pdt = 0.f;
#pragma unroll
    for (int tp = 0; tp < 5; ++tp) pre[tp] = 0.f;
    int j = scan_row(0, dir);
#define SSD_LOAD(jj) do { const int lo_ = ((jj) < CTXL) ? 0 : CTXL, hi_ = ((jj) < CTXL) ? CTXL : RB; \
        if (ch >= 0) { _Pragma("unroll") for (int tp = 0; tp < 5; ++tp) { const int jn = (jj) + tp - 2; pre[tp] = (jn >= lo_ && jn < hi_) ? bf2f(U[(size_t)jn * NU + UXBC + ch]) : 0.f; } } \
        pdt = US[(size_t)(jj) * USL + 16 + dir * 16 + head]; } while (0)
    SSD_LOAD(j);
    for (int step = 0; step < RB; ++step) {
        if (ch >= 0) { float s = cb;
#pragma unroll
            for (int tp = 0; tp < 5; ++tp) s += cw[tp] * pre[tp];
            s = silu_f(s);
            if (tid < 64) xs[tid] = s; else if (tid < 192) Bs[tid - 64] = s; else Cs[tid - 192] = s; }
        const float dt = softplus_f(pdt + dtb), dA = expf(dt * av);
        const int jcur = j;
        if (step + 1 < RB) { j = scan_row(step + 1, dir); SSD_LOAD(j); }
        __syncthreads();
        const float xv = xs[p] * dt; float yp = 0.f;
#pragma unroll
        for (int i = 0; i < 16; ++i) { const int n = ng * 16 + i; h[i] = dA * h[i] + Bs[n] * xv; yp += Cs[n] * h[i]; }
        part[ng * 64 + p] = yp;
        __syncthreads();
        if (tid < 64) { float y = 0.f;
#pragma unroll
            for (int g = 0; g < 8; ++g) y += part[g * 64 + tid];
            Yo[(size_t)jcur * 1024 + head * 64 + tid] = y; }
    }
#undef SSD_LOAD
}
__device__ __forceinline__ void rot4(float (&q)[8], const f32x4 c4, const f32x4 s4) {
    float t;
    t = q[0] * c4.x - q[1] * s4.x; q[1] = q[0] * s4.x + q[1] * c4.x; q[0] = t;
    t = q[2] * c4.y - q[3] * s4.y; q[3] = q[2] * s4.y + q[3] * c4.y; q[2] = t;
    t = q[4] * c4.z - q[5] * s4.z; q[5] = q[4] * s4.z + q[5] * c4.z; q[4] = t;
    t = q[6] * c4.w - q[7] * s4.w; q[7] = q[6] * s4.w + q[7] * c4.w; q[6] = t;
}
__device__ __forceinline__ void unpack8(const v4u w, float (&q)[8]) { q[0] = bflo(w.x); q[1] = bfhi(w.x); q[2] = bflo(w.y); q[3] = bfhi(w.y); q[4] = bflo(w.z); q[5] = bfhi(w.z); q[6] = bflo(w.w); q[7] = bfhi(w.w); }
__device__ __forceinline__ void attn_simple_task(KArgs& a, int l, int bl, int j, int g, LAS float* qs, LAS float* ps, int lane) {
    const bf16* Ub = (const bf16*)(a.ws + WS_U) + (size_t)bl * RB * NU;
    const bf16* urow = Ub + (size_t)j * NU;
    const float* rc = (const float*)(a.ws + WS_ROPE); const float* rs = rc + 2048 * 64;
    const bool is_main = j >= CTXL; const int t = j - CTXL;
    {
        float q[8]; unpack8(*(const v4u*)(urow + UQ + g * 512 + lane * 8), q);
        if (is_main) { const int p0 = ((lane * 8) & 127) >> 1; rot4(q, *(const f32x4*)(rc + t * 64 + p0), *(const f32x4*)(rs + t * 64 + p0)); }
#pragma unroll
        for (int i = 0; i < 8; ++i) qs[lane * 8 + i] = q[i] * 0.08838834764831845f;
    }
    LDS_WAIT(); asm volatile("" ::: "memory");
    const int nloc = is_main ? 257 : 0, nk = nloc + CTXL;
    float s[9][4];
#pragma unroll
    for (int i = 0; i < 9; ++i) {
        const int kk = lane + 64 * i;
        bool valid = kk < nk, rope = false; int krow = 0;
        if (kk < nloc) { const int pos = t - 128 + kk; valid = (pos >= 0 && pos < SEQ); krow = CTXL + pos; rope = true; } else krow = kk - nloc;
        float d0 = 0.f, d1 = 0.f, d2 = 0.f, d3 = 0.f;
        if (valid) {
            const bf16* kr = Ub + (size_t)krow * NU + UK + g * 128; const int pos = krow - CTXL;
            for (int ch = 0; ch < 16; ++ch) {
                float k[8]; unpack8(*(const v4u*)(kr + ch * 8), k);
                if (rope) rot4(k, *(const f32x4*)(rc + pos * 64 + ch * 4), *(const f32x4*)(rs + pos * 64 + ch * 4));
#pragma unroll
                for (int i2 = 0; i2 < 8; ++i2) { const float kv = k[i2]; d0 += kv * qs[ch * 8 + i2]; d1 += kv * qs[128 + ch * 8 + i2]; d2 += kv * qs[256 + ch * 8 + i2]; d3 += kv * qs[384 + ch * 8 + i2]; }
            }
        }
        s[i][0] = valid ? d0 : -INFINITY; s[i][1] = valid ? d1 : -INFINITY; s[i][2] = valid ? d2 : -INFINITY; s[i][3] = valid ? d3 : -INFINITY;
    }
    float inv[4];
#pragma unroll
    for (int h = 0; h < 4; ++h) {
        const float sink = a.in[10][l * 8 + g * 4 + h]; float mx = sink;
#pragma unroll
        for (int i = 0; i < 9; ++i) mx = fmaxf(mx, s[i][h]);
        mx = wave_max(mx); float sum = 0.f;
#pragma unroll
        for (int i = 0; i < 9; ++i) { const float pv = expf(s[i][h] - mx); s[i][h] = pv; sum += pv; }
        sum = wave_sum(sum) + expf(sink - mx); inv[h] = 1.0f / sum;
    }
#pragma unroll
    for (int i = 0; i < 9; ++i) *(LAS f32x4*)(ps + (lane + 64 * i) * 4) = (f32x4){s[i][0], s[i][1], s[i][2], s[i][3]};
    LDS_WAIT(); asm volatile("" ::: "memory");
    float o[4][2];
#pragma unroll
    for (int h = 0; h < 4; ++h) { o[h][0] = 0.f; o[h][1] = 0.f; }
    for (int kk = 0; kk < nk; ++kk) {
        int krow;
        if (kk < nloc) { const int pos = t - 128 + kk; if (pos < 0 || pos >= SEQ) continue; krow = CTXL + pos; } else krow = kk - nloc;
        const unsigned w = *(const unsigned*)(Ub + (size_t)krow * NU + UV + g * 128 + 2 * lane); const float v0 = bflo(w), v1 = bfhi(w);
        const f32x4 pp = *(const LAS f32x4*)(ps + kk * 4);
        o[0][0] += pp.x * v0; o[0][1] += pp.x * v1; o[1][0] += pp.y * v0; o[1][1] += pp.y * v1; o[2][0] += pp.z * v0; o[2][1] += pp.z * v1; o[3][0] += pp.w * v0; o[3][1] += pp.w * v1;
    }
    bf16* orow = (bf16*)(a.ws + WS_OBR) + (size_t)(bl * RB + j) * LDK3;
#pragma unroll
    for (int h = 0; h < 4; ++h) { const int head = g * 4 + h; const unsigned zw = *(const unsigned*)(urow + UAZ + head * 128 + 2 * lane);
        *(unsigned*)(orow + head * 128 + 2 * lane) = pk2(o[h][0] * inv[h] * silu_f(bflo(zw)), o[h][1] * inv[h] * silu_f(bfhi(zw))); }
    LDS_WAIT(); asm volatile("" ::: "memory");
}
typedef __attribute__((address_space(3))) unsigned char lds_u8;
__device__ __forceinline__ bf16x8 ldfrag(const lds_u8* base, int row, int ld_bytes, int kbyte) { return *(const LAS bf16x8*)(base + row * ld_bytes + kbyte); }
#define MFMA16(a_, b_, c_) __builtin_amdgcn_mfma_f32_16x16x32_bf16((a_), (b_), (c_), 0, 0, 0)
__device__ __forceinline__ unsigned lds_addr(const lds_u8* p) { return (unsigned)(size_t)p; }
__device__ __forceinline__ unsigned tr_lane(int lane, int RS) { return (unsigned)(((lane & 15) >> 2) * RS + (lane & 3) * 8); }
typedef short v4s_t __attribute__((ext_vector_type(4)));
__device__ __forceinline__ bf16x8 tr_frag(unsigned a0, unsigned a1) {
    const v4s_t lo = __builtin_amdgcn_ds_read_tr16_b64_v4i16((LAS v4s_t*)a0), hi = __builtin_amdgcn_ds_read_tr16_b64_v4i16((LAS v4s_t*)a1);
    return (bf16x8){lo[0], lo[1], lo[2], lo[3], hi[0], hi[1], hi[2], hi[3]};
}
template <int STEP, int HI> __device__ __forceinline__ void tr_frags2(unsigned base, bf16x8 (&f)[2]) { f[0] = tr_frag(base, base + HI); f[1] = tr_frag(base + STEP, base + STEP + HI); }
template <int STEP, int HI> __device__ __forceinline__ void tr_frags4(unsigned base, bf16x8 (&f)[4]) {
#pragma unroll
    for (int i = 0; i < 4; ++i) f[i] = tr_frag(base + i * STEP, base + i * STEP + HI); }
template <int STEP, int HI> __device__ __forceinline__ void tr_frags5(unsigned base, bf16x8 (&f)[5]) {
#pragma unroll
    for (int i = 0; i < 5; ++i) f[i] = tr_frag(base + i * STEP, base + i * STEP + HI); }
__device__ __forceinline__ bf16x8 scale_frag(bf16x8 f, f32x4 w0, f32x4 w1) {
    const v4u u = __builtin_bit_cast(v4u, f); v4u w;
    w.x = pk2(bflo(u.x) * w0[0], bfhi(u.x) * w0[1]); w.y = pk2(bflo(u.y) * w0[2], bfhi(u.y) * w0[3]); w.z = pk2(bflo(u.z) * w1[0], bfhi(u.z) * w1[1]); w.w = pk2(bflo(u.w) * w1[2], bfhi(u.w) * w1[3]);
    return __builtin_bit_cast(bf16x8, w);
}

__device__ __forceinline__ int chunk_r0(int c, int dir) { return dir == 0 ? 64 * c : (c < 4 ? 192 - 64 * c : 2240 - 64 * (c - 4)); }
__device__ __forceinline__ void mlsc_unit(KArgs& a, int l, int unit, LAS unsigned char* lds, int tid) {
    const int dir = unit & 1, head = (unit >> 1) & 3, bl = unit >> 3, lane = tid & 63, wid = __builtin_amdgcn_readfirstlane(tid >> 6);
    const float* US = (const float*)(a.ws + WS_US) + (size_t)bl * RB * USL;
    const float gbi = a.in[11][l * 16 + (dir * 2) * 4 + head], gbf = a.in[11][l * 16 + (dir * 2 + 1) * 4 + head];
    LAS float* cs = (LAS float*)lds;
    float av[5], bb[5], cmv[5];
#pragma unroll
    for (int k = 0; k < 5; ++k) { const int c = wid + 8 * k; av[k] = 0.f; bb[k] = 0.f; cmv[k] = 0.f;
        if (c < 36) { const size_t r = (size_t)scan_row(64 * c + lane, dir) * USL; const float gi = US[r + (dir * 2) * 4 + head] + gbi, lf = logsigmoid_f(US[r + (dir * 2 + 1) * 4 + head] + gbf);
            float b = lf;
#pragma unroll
            for (int o = 1; o < 64; o <<= 1) { const float t = shup(b, o); if (lane >= o) b += t; }
            const float a_ = gi - b; float cm = a_;
#pragma unroll
            for (int o = 1; o < 64; o <<= 1) { const float t = shup(cm, o); if (lane >= o) cm = fmaxf(cm, t); }
            av[k] = a_; bb[k] = b; cmv[k] = cm; if (lane == 63) { cs[c] = cm; cs[64 + c] = b; } } }
    __syncthreads();
    if (tid == 0) { float m = 0.f; for (int c = 0; c < 36; ++c) { cs[128 + c] = m; m = cs[64 + c] + fmaxf(m, cs[c]); } }
    __syncthreads();
    float* MS = (float*)(a.ws + WS_MSC) + (size_t)unit * 36 * 384;
#pragma unroll
    for (int k = 0; k < 5; ++k) { const int c = wid + 8 * k;
        if (c < 36) { const float mp = cs[128 + c], Mt = fmaxf(mp, cmv[k]), M63 = fmaxf(mp, cs[c]); float* rec = MS + (size_t)c * 384;
            rec[lane] = av[k] * L2E; rec[64 + lane] = Mt * L2E; rec[128 + lane] = expf(mp - Mt); rec[192 + lane] = expf(-(bb[k] + Mt)); rec[256 + lane] = expf(av[k] - M63) * 0.0625f;
            if (lane == 0) rec[320] = expf(mp - M63); } }
    __syncthreads();
}
__device__ __forceinline__ void sdsc_task(KArgs& a, int l, int T, int lane) {
    const int head = T & 15, c = (T >> 4) % 36, rest = T / (16 * 36), dir = rest & 1, bl = rest >> 1;
    const float* US = (const float*)(a.ws + WS_US) + (size_t)bl * RB * USL;
    const float dtb = a.in[15][l * 32 + dir * 16 + head], av = -expf(a.in[16][l * 32 + dir * 16 + head]);
    const int R0 = chunk_r0(c, dir), row = dir ? (R0 + 63 - lane) : (R0 + lane);
    const float dt = softplus_f(US[(size_t)row * USL + 16 + dir * 16 + head] + dtb); float cum = dt * av;
#pragma unroll
    for (int o = 1; o < 64; o <<= 1) { const float t = shup(cum, o); if (lane >= o) cum += t; }
    const float c63 = shidx(cum, 63);
    float* rec = (float*)(a.ws + WS_SSC) + ((size_t)((bl * 2 + dir) * 36 + c) * 16 + head) * 320;
    rec[lane] = dt; rec[64 + lane] = cum * L2E; rec[128 + lane] = expf(cum); rec[192 + lane] = expf(c63 - cum) * dt; if (lane == 0) rec[256] = expf(c63);
}

constexpr int ML_LD = 528, ML_VLD = 144, ML_WLD = 176;
constexpr int MLO_Q = 0, MLO_K = 33792, MLO_V = 67584, MLO_S = 78848, MLO_CT = 88064, MLO_SC = 130304, MLO_END = 132096;
static_assert(MLO_END <= MISC_OFF, "mLSTM LDS map");
constexpr size_t WS_SRAW = WS_SC + 80 * MiB;
__device__ __forceinline__ void score_unit(KArgs& a, int unit, LAS unsigned char* lds, int tid) {
    const int blk = unit % 36, head = (unit / 36) & 3, bl = unit / 144;
    const int lane = tid & 63, wid = __builtin_amdgcn_readfirstlane(tid >> 6), fr = lane & 15, fq = lane >> 4;
    const bf16* U = (const bf16*)(a.ws + WS_U) + ((size_t)bl * RB + 64 * blk) * NU + head * 256;
    v4u q4[4], k4[4];
#pragma unroll
    for (int i = 0; i < 4; ++i) { const int ch = tid + 512 * i, s = ch >> 5, c16 = ch & 31; const bf16* ur = U + (size_t)s * NU + c16 * 8; q4[i] = *(const v4u*)(ur + UMQ); k4[i] = *(const v4u*)(ur + UMK); }
    __syncthreads();
#pragma unroll
    for (int i = 0; i < 4; ++i) { const int ch = tid + 512 * i, s = ch >> 5, c16 = ch & 31; *(LAS v4u*)(lds + MLO_Q + s * ML_LD + c16 * 16) = q4[i]; *(LAS v4u*)(lds + MLO_K + s * ML_LD + c16 * 16) = k4[i]; }
    __syncthreads();
    { const int tm = wid >> 1, tn0 = (wid & 1) * 2;
        f32x4 sa0 = (f32x4){0.f, 0.f, 0.f, 0.f}, sa1 = sa0;
#pragma unroll
        for (int ks = 0; ks < 8; ++ks) { const bf16x8 qf = ldfrag(lds + MLO_Q, tm * 16 + fr, ML_LD, ks * 64 + fq * 16);
            sa0 = MFMA16(ldfrag(lds + MLO_K, tn0 * 16 + fr, ML_LD, ks * 64 + fq * 16), qf, sa0); sa1 = MFMA16(ldfrag(lds + MLO_K, (tn0 + 1) * 16 + fr, ML_LD, ks * 64 + fq * 16), qf, sa1); }
        const int t = tm * 16 + fr;
#pragma unroll
        for (int j = 0; j < 2; ++j) { const int s0 = (tn0 + j) * 16 + fq * 4; const f32x4 sv = (j ? sa1 : sa0) * 0.0625f;
            v2u o; o.x = pk2(sv[0], sv[1]); o.y = pk2(sv[2], sv[3]); *(LAS v2u*)(lds + MLO_S + t * ML_VLD + s0 * 2) = o; } }
    __syncthreads();
    { const int row = tid >> 3, pc = tid & 7; bf16* dst = (bf16*)(a.ws + WS_SRAW) + ((size_t)(bl * 4 + head) * 36 + blk) * 4096;
        *(v4u*)(dst + row * 64 + pc * 8) = *(const LAS v4u*)(lds + MLO_S + row * ML_VLD + pc * 16); }
}
__device__ __forceinline__ void mlstm_chunk_unit(KArgs& a, int l, int unit, LAS unsigned char* lds, int tid_in) {
    const int es = unit & 3, dir = (unit >> 2) & 1, head = (unit >> 3) & 3, bl = unit >> 5;
    const int wid = __builtin_amdgcn_readfirstlane(tid_in >> 6);
    const bf16* U = (const bf16*)(a.ws + WS_U) + (size_t)bl * RB * NU;
    const float* MS = (const float*)(a.ws + WS_MSC) + (size_t)(bl * 8 + head * 2 + dir) * 36 * 384;
    bf16* H = (bf16*)(a.ws + WS_SC) + (size_t)dir * RP * 1024 + (size_t)bl * RB * 1024 + head * 256 + es * 64;
    const lds_u8* Qs = lds + MLO_Q; const lds_u8* Ks = lds + MLO_K; const lds_u8* Vs = lds + MLO_V; const lds_u8* Ss = lds + MLO_S; const lds_u8* CTs = lds + MLO_CT;
    LAS float* sc = (LAS float*)(lds + MLO_SC);
    for (int i = tid_in; i < (MLO_SC - MLO_CT) / 4; i += 512) ((LAS unsigned*)(lds + MLO_CT))[i] = 0u;
    for (int i = tid_in; i < 64 * 24; i += 512) { const int r = i / 24, c = 64 + i % 24; ((LAS bf16*)(lds + MLO_V))[r * 88 + c] = (c == 64) ? (bf16)0x3F80 : (bf16)0; }
    f32x4 st[2][5];
#pragma unroll
    for (int i = 0; i < 2; ++i)
#pragma unroll
        for (int j = 0; j < 5; ++j) st[i][j] = (f32x4){0.f, 0.f, 0.f, 0.f};
    v4u pq[4], pk[4], pv, ps; f32x4 psc = (f32x4){0.f, 0.f, 0.f, 0.f}, pa[2]; float pm;
    const bf16* SR = (const bf16*)(a.ws + WS_SRAW) + (size_t)(bl * 4 + head) * 36 * 4096;
#define MLC_LOAD(cc, tid) do { \
        _Pragma("unroll") for (int i = 0; i < 4; ++i) { const int ch = (tid) + 512 * i, s = ch >> 5, c16 = ch & 31; const bf16* ur = U + (size_t)scan_row(64 * (cc) + s, dir) * NU + head * 256 + c16 * 8; \
            pq[i] = *(const v4u*)(ur + UMQ); pk[i] = *(const v4u*)(ur + UMK); } \
        { const int s = (tid) >> 3, c8 = (tid) & 7; pv = *(const v4u*)(U + (size_t)scan_row(64 * (cc) + s, dir) * NU + UMV + head * 256 + es * 64 + c8 * 8); } \
        { const float* rec = MS + (size_t)(cc) * 384; if ((tid) < 81) psc = *(const f32x4*)(rec + 4 * (tid)); \
          const int t_ = (tid) >> 3, g_ = (tid) & 7; const bf16* sb = SR + (size_t)(chunk_r0((cc), dir) >> 6) * 4096; \
          ps = dir ? *(const v4u*)(sb + (63 - t_) * 64 + 56 - 8 * g_) : *(const v4u*)(sb + t_ * 64 + 8 * g_); \
          pa[0] = *(const f32x4*)(rec + 8 * g_); pa[1] = *(const f32x4*)(rec + 8 * g_ + 4); pm = rec[64 + t_]; } } while (0)
    MLC_LOAD(0, tid_in);
    __syncthreads();
    for (int c = 0; c < RB / 64; ++c) {
        int tid = tid_in; asm volatile("" : "+v"(tid));
        const int lane = tid & 63, fr = lane & 15, fq = lane >> 4;
#pragma unroll
        for (int i = 0; i < 4; ++i) { const int ch = tid + 512 * i, s = ch >> 5, c16 = ch & 31; *(LAS v4u*)(lds + MLO_Q + s * ML_LD + c16 * 16) = pq[i]; *(LAS v4u*)(lds + MLO_K + s * ML_LD + c16 * 16) = pk[i]; }
        if (tid < 81) *(LAS f32x4*)(sc + 4 * tid) = psc;
        if (c > 0) {
#pragma unroll
            for (int dt = 0; dt < 2; ++dt)
#pragma unroll
                for (int te = 0; te < 5; ++te) { v2u o; o.x = pk2(st[dt][te][0], st[dt][te][1]); o.y = pk2(st[dt][te][2], st[dt][te][3]);
                    *(LAS v2u*)(lds + MLO_CT + (te * 16 + fr) * ML_LD + ((2 * wid + dt) * 16 + fq * 4) * 2) = o; }
        }
        {
            const int s = tid >> 3, c8 = tid & 7; *(LAS v4u*)(lds + MLO_V + s * ML_WLD + c8 * 16) = pv;
        }
        {
            const int t_ = tid >> 3, g_ = tid & 7; float r[8], w[8]; unpack8(ps, r);
#pragma unroll
            for (int j = 0; j < 8; ++j) { const float rv = dir ? r[7 - j] : r[j]; w[j] = (8 * g_ + j <= t_) ? rv * ex2(pa[j >> 2][j & 3] - pm) : 0.f; }
            v4u o; o.x = pk2(w[0], w[1]); o.y = pk2(w[2], w[3]); o.z = pk2(w[4], w[5]); o.w = pk2(w[6], w[7]);
            *(LAS v4u*)(lds + MLO_S + t_ * ML_VLD + g_ * 16) = o;
        }
        if (c + 1 < RB / 64) MLC_LOAD(c + 1, tid);
        __syncthreads();
        for (int rp2 = 0; rp2 < ((MK_DUP == 21) ? 2 : 1); ++rp2) {
            const int tm = wid & 3, te0 = (wid < 4) ? 0 : 2;
            f32x4 a1[3], a2[3];
#pragma unroll
            for (int i = 0; i < 3; ++i) { a1[i] = (f32x4){0.f, 0.f, 0.f, 0.f}; a2[i] = a1[i]; }
#pragma unroll
            for (int ks = 0; ks < 8; ++ks) { const bf16x8 qf = ldfrag(Qs, tm * 16 + fr, ML_LD, ks * 64 + fq * 16);
#pragma unroll
                for (int i = 0; i < 3; ++i) a1[i] = MFMA16(ldfrag(CTs, ((i < 2) ? te0 + i : 4) * 16 + fr, ML_LD, ks * 64 + fq * 16), qf, a1[i]); }
#pragma unroll
            for (int ks = 0; ks < 2; ++ks) { const bf16x8 sf = ldfrag(Ss, tm * 16 + fr, ML_VLD, ks * 64 + fq * 16);
                const unsigned vb = lds_addr(Vs) + (ks * 32 + 8 * fq) * ML_WLD + tr_lane(lane, ML_WLD);
                bf16x8 vf2[2]; tr_frags2<32, 4 * ML_WLD>(vb + te0 * 32, vf2); const bf16x8 vf4 = tr_frag(vb + 4 * 32, vb + 4 * 32 + 4 * ML_WLD);
                a2[0] = MFMA16(vf2[0], sf, a2[0]); a2[1] = MFMA16(vf2[1], sf, a2[1]); a2[2] = MFMA16(vf4, sf, a2[2]); }
            const int t = tm * 16 + fr; const float ei = sc[128 + t];
#pragma unroll
            for (int i = 0; i < 3; ++i) a1[i] = a1[i] * ei + a2[i];
            const float den = shidx(a1[2][0], fr);
            const float inv = 1.0f / fmaxf(fabsf(den), sc[192 + t]);
            bf16* hrow = H + (size_t)scan_row(64 * c + t, dir) * 1024;
#pragma unroll
            for (int i = 0; i < 2; ++i) { const f32x4 hv = a1[i] * inv; v2u w; w.x = pk2(hv[0], hv[1]); w.y = pk2(hv[2], hv[3]); *(v2u*)(hrow + (te0 + i) * 16 + fq * 4) = w; }
        }
        {
            const float sp = sc[320];
#pragma unroll
            for (int i = 0; i < 2; ++i)
#pragma unroll
                for (int j = 0; j < 5; ++j) st[i][j] *= sp;
#pragma unroll
            for (int ks = 0; ks < 2; ++ks) {
                bf16x8 kf[2];
                const f32x4 wd0 = *(const LAS f32x4*)(sc + 256 + ks * 32 + fq * 8), wd1 = *(const LAS f32x4*)(sc + 256 + ks * 32 + fq * 8 + 4);
                { const unsigned ka = lds_addr(Ks) + (ks * 32 + 8 * fq) * ML_LD + (2 * wid) * 32 + tr_lane(lane, ML_LD); tr_frags2<32, 4 * ML_LD>(ka, kf); kf[0] = scale_frag(kf[0], wd0, wd1); kf[1] = scale_frag(kf[1], wd0, wd1); }
                const unsigned vb = lds_addr(Vs) + (ks * 32 + 8 * fq) * ML_WLD + tr_lane(lane, ML_WLD);
                bf16x8 vfa[5]; tr_frags5<32, 4 * ML_WLD>(vb, vfa);
#pragma unroll
                for (int te = 0; te < 5; ++te) { const bf16x8 vf = vfa[te];
                    st[0][te] = MFMA16(kf[0], vf, st[0][te]); st[1][te] = MFMA16(kf[1], vf, st[1][te]); }
            }
        }
        __syncthreads();
    }
#undef MLC_LOAD
}

__device__ __forceinline__ void rope_unit(KArgs& a, int unit, int tid) {
    const int bl = unit >> 6, t0 = (unit & 63) * 32;
    const bf16* Ub = (const bf16*)(a.ws + WS_U) + (size_t)(bl * RB + CTXL + t0) * NU; bf16* Qb = (bf16*)(a.ws + WS_QK) + (size_t)(bl * RB + CTXL + t0) * 1280;
    const float* rc = (const float*)(a.ws + WS_ROPE); const float* rs = rc + 2048 * 64;
    for (int i0 = tid; i0 < 32 * 160; i0 += 512 * 5) {
        v4u in[5]; f32x4 cs[5], sn[5];
#pragma unroll
        for (int j = 0; j < 5; ++j) { const int i = i0 + 512 * j, r = i / 160, pc = i % 160; in[j] = *(const v4u*)(Ub + (size_t)r * NU + pc * 8);
            const int p0 = (t0 + r) * 64 + ((pc * 8) & 127) / 2; cs[j] = *(const f32x4*)(rc + p0); sn[j] = *(const f32x4*)(rs + p0); }
#pragma unroll
        for (int j = 0; j < 5; ++j) { const int i = i0 + 512 * j, r = i / 160, pc = i % 160;
            float q[8]; unpack8(in[j], q); rot4(q, cs[j], sn[j]);
            v4u w; w.x = pk2(q[0], q[1]); w.y = pk2(q[2], q[3]); w.z = pk2(q[4], q[5]); w.w = pk2(q[6], q[7]); *(v4u*)(Qb + (size_t)r * 1280 + pc * 8) = w; } }
}

__device__ __forceinline__ void conv_unit(KArgs& a, int l, int unit, int tid) {
    const int rb0 = unit * 32, j0 = rb0 % RB, lo = rb0 - j0 + ((j0 < CTXL) ? 0 : CTXL), hi = rb0 - j0 + ((j0 < CTXL) ? CTXL : RB);
    const bf16* U = (const bf16*)(a.ws + WS_U); bf16* XC = (bf16*)(a.ws + WS_XC);
    for (int t = tid; t < 768; t += 512) {
        const int cg = t % 192, r0 = rb0 + (t / 192) * 8, ch = cg * 8;
        v4u pre[12];
#pragma unroll
        for (int i = 0; i < 12; ++i) { const int row = r0 - 2 + i; const int rc = row < lo ? lo : (row >= hi ? hi - 1 : row); const v4u w = *(const v4u*)(U + (size_t)rc * NU + UXBC + ch); pre[i] = (rc == row) ? w : (v4u){0u, 0u, 0u, 0u}; }
        f32x4 cw[5][2], cb[2];
#pragma unroll
        for (int tp = 0; tp < 5; ++tp) { cw[tp][0] = *(const f32x4*)(a.in[13] + (size_t)(l * 5 + tp) * 1536 + ch); cw[tp][1] = *(const f32x4*)(a.in[13] + (size_t)(l * 5 + tp) * 1536 + ch + 4); }
        cb[0] = *(const f32x4*)(a.in[14] + l * 1536 + ch); cb[1] = *(const f32x4*)(a.in[14] + l * 1536 + ch + 4);
#pragma unroll
        for (int i = 0; i < 8; ++i) { f32x4 s0 = cb[0], s1 = cb[1];
#pragma unroll
            for (int tp = 0; tp < 5; ++tp) { const v4u w = pre[i + tp];
                s0 += cw[tp][0] * (f32x4){bflo(w.x), bfhi(w.x), bflo(w.y), bfhi(w.y)}; s1 += cw[tp][1] * (f32x4){bflo(w.z), bfhi(w.z), bflo(w.w), bfhi(w.w)}; }
            v4u o; o.x = pk2(s0[0] * fsig(s0[0]), s0[1] * fsig(s0[1])); o.y = pk2(s0[2] * fsig(s0[2]), s0[3] * fsig(s0[3])); o.z = pk2(s1[0] * fsig(s1[0]), s1[1] * fsig(s1[1])); o.w = pk2(s1[2] * fsig(s1[2]), s1[3] * fsig(s1[3]));
            *(v4u*)(XC + (size_t)(r0 + i) * 1536 + ch) = o; }
    }
}

constexpr int SD_CLD = 272, SD_XLD = 144, SD_WLD = 528;
constexpr int SDO_C = 0, SDO_B = 17408, SDO_X = 34816, SDO_MX = 68608, SDO_SC = 105472, SDO_END = 110592;
template <int DIR> __device__ __forceinline__ void ssd_chunk_unit_d(KArgs& a, int l, int unit, LAS unsigned char* lds, int tid) {
    constexpr int dir = DIR; const int hq = unit & 1, g = (unit >> 1) & 1, bl = unit >> 3;
    const int lane = tid & 63, wid = __builtin_amdgcn_readfirstlane(tid >> 6), fr = lane & 15, fq = lane >> 4;
    const int hl = wid >> 1, half = wid & 1, head = g * 8 + hq * 4 + hl;
    const bf16* XC = (const bf16*)(a.ws + WS_XC) + (size_t)bl * RB * 1536;
    const float* SS = (const float*)(a.ws + WS_SSC) + ((size_t)(bl * 2 + dir) * 36 * 16 + g * 8 + hq * 4) * 320;
    bf16* Yo = (bf16*)(a.ws + WS_SC) + (size_t)(2 + dir) * RP * 1024 + (size_t)bl * RB * 1024 + head * 64;
    const lds_u8* Cs = lds + SDO_C; const lds_u8* Bs = lds + SDO_B; const lds_u8* Xs = lds + SDO_X; const lds_u8* MXs = lds + SDO_MX + hl * 9216;
    LAS float* scw = (LAS float*)(lds + SDO_SC) + hl * 320;
    f32x4 st[8][2];
#pragma unroll
    for (int i = 0; i < 8; ++i) { st[i][0] = (f32x4){0.f, 0.f, 0.f, 0.f}; st[i][1] = st[i][0]; }
    v4u px[4], pb[2], pc[2]; f32x4 psc = (f32x4){0.f, 0.f, 0.f, 0.f};
#define SDC_LOAD(cc) do { const int R0_ = chunk_r0((cc), dir); \
        _Pragma("unroll") for (int i = 0; i < 4; ++i) { const int id = tid + 512 * i; px[i] = *(const v4u*)(XC + (size_t)(R0_ + (id >> 5)) * 1536 + (g * 8 + hq * 4) * 64 + (id & 31) * 8); } \
        _Pragma("unroll") for (int i = 0; i < 2; ++i) { const int id = tid + 512 * i; const bf16* xr = XC + (size_t)(R0_ + (id >> 4)) * 1536 + g * 128 + (id & 15) * 8; pb[i] = *(const v4u*)(xr + 1024); pc[i] = *(const v4u*)(xr + 1280); } \
        { const float* rec = SS + (size_t)(cc) * 16 * 320; if (tid < 320) psc = *(const f32x4*)(rec + 4 * tid); } } while (0)
    SDC_LOAD(0);
    const int tid_outer = tid;
    for (int c = 0; c < RB / 64; ++c) {
        const int R0 = chunk_r0(c, dir);
        int tid = tid_outer; asm volatile("" : "+v"(tid));
        const int lane = tid & 63, fr = lane & 15, fq = lane >> 4;
        if (tid < 320) *(LAS f32x4*)(lds + SDO_SC + tid * 16) = psc;
#pragma unroll
        for (int i = 0; i < 2; ++i) { const int id = tid + 512 * i, rr = id >> 4, s = dir ? 63 - rr : rr; *(LAS v4u*)(lds + SDO_B + s * SD_CLD + (id & 15) * 16) = pb[i]; *(LAS v4u*)(lds + SDO_C + s * SD_CLD + (id & 15) * 16) = pc[i]; }
#pragma unroll
        for (int i = 0; i < 4; ++i) { const int id = tid + 512 * i, rr = id >> 5, s = dir ? 63 - rr : rr; *(LAS v4u*)(lds + SDO_X + s * SD_WLD + (id & 31) * 16) = px[i]; }
        if (c + 1 < RB / 64) SDC_LOAD(c + 1);
        __syncthreads();
        {
#pragma unroll
            for (int ti = 0; ti < 2; ++ti) { const int tt = 2 * half + ti;
                f32x4 cbacc[4];
#pragma unroll
                for (int si = 0; si < 4; ++si) cbacc[si] = (f32x4){0.f, 0.f, 0.f, 0.f};
#pragma unroll
                for (int ks = 0; ks < 4; ++ks) { const bf16x8 cf = ldfrag(Cs, tt * 16 + fr, SD_CLD, ks * 64 + fq * 16);
#pragma unroll
                    for (int si = 0; si < 4; ++si) cbacc[si] = MFMA16(ldfrag(Bs, si * 16 + fr, SD_CLD, ks * 64 + fq * 16), cf, cbacc[si]); }
                const int t = tt * 16 + fr; const float cumt = scw[64 + t];
#pragma unroll
                for (int si = 0; si < 4; ++si) { const int s0 = si * 16 + fq * 4; const f32x4 c4 = *(const LAS f32x4*)(scw + 64 + s0), d4 = *(const LAS f32x4*)(scw + s0);
                    float w[4];
#pragma unroll
                    for (int r = 0; r < 4; ++r) w[r] = (s0 + r <= t) ? cbacc[si][r] * d4[r] * ex2(cumt - c4[r]) : 0.f;
                    v2u o; o.x = pk2(w[0], w[1]); o.y = pk2(w[2], w[3]); *(LAS v2u*)(lds + SDO_MX + hl * 9216 + t * SD_XLD + s0 * 2) = o; } }
        }
        __syncthreads();
        {
            f32x4 acc[4][2];
#pragma unroll
            for (int i = 0; i < 4; ++i) { acc[i][0] = (f32x4){0.f, 0.f, 0.f, 0.f}; acc[i][1] = acc[i][0]; }
#pragma unroll
            for (int ks = 0; ks < 4; ++ks) {
                bf16x8 hb[2];
#pragma unroll
                for (int pt = 0; pt < 2; ++pt) { const f32x4 s0 = st[2 * ks][pt], s1 = st[2 * ks + 1][pt];
                    v4u w; w.x = pk2(s0[0], s0[1]); w.y = pk2(s0[2], s0[3]); w.z = pk2(s1[0], s1[1]); w.w = pk2(s1[2], s1[3]); hb[pt] = __builtin_bit_cast(bf16x8, w); }
#pragma unroll
                for (int tt = 0; tt < 4; ++tt) { const lds_u8* cr = Cs + (tt * 16 + fr) * SD_CLD + (ks * 32 + 4 * fq) * 2;
                    const v2u c0 = *(const LAS v2u*)cr, c1 = *(const LAS v2u*)(cr + 32);
                    v4u cw; cw.x = c0.x; cw.y = c0.y; cw.z = c1.x; cw.w = c1.y; const bf16x8 cf = __builtin_bit_cast(bf16x8, cw);
                    acc[tt][0] = MFMA16(hb[0], cf, acc[tt][0]); acc[tt][1] = MFMA16(hb[1], cf, acc[tt][1]); }
            }
#pragma unroll
            for (int tt = 0; tt < 4; ++tt) { const float e1 = scw[128 + tt * 16 + fr]; acc[tt][0] *= e1; acc[tt][1] *= e1; }
            const float dA = scw[256];
#pragma unroll
            for (int i = 0; i < 8; ++i) { st[i][0] *= dA; st[i][1] *= dA; }
#pragma unroll
            for (int ks = 0; ks < 2; ++ks) {
                const unsigned xb = lds_addr(Xs) + (ks * 32 + 8 * fq) * SD_WLD + (hl * 64 + (2 * half) * 16) * 2 + tr_lane(lane, SD_WLD);
                bf16x8 xfa[2]; tr_frags2<32, 4 * SD_WLD>(xb, xfa); const bf16x8 xf0 = xfa[0], xf1 = xfa[1];
#pragma unroll
                for (int tt = 0; tt < 4; ++tt) { const bf16x8 mf = ldfrag(MXs, tt * 16 + fr, SD_XLD, ks * 64 + fq * 16); acc[tt][0] = MFMA16(xf0, mf, acc[tt][0]); acc[tt][1] = MFMA16(xf1, mf, acc[tt][1]); }
                const f32x4 we0 = *(const LAS f32x4*)(scw + 192 + ks * 32 + 8 * fq), we1 = *(const LAS f32x4*)(scw + 192 + ks * 32 + 8 * fq + 4);
                const unsigned bb = lds_addr(Bs) + (ks * 32 + 8 * fq) * SD_CLD + tr_lane(lane, SD_CLD);
                const bf16x8 xw0 = scale_frag(xf0, we0, we1), xw1 = scale_frag(xf1, we0, we1);
#pragma unroll
                for (int n4 = 0; n4 < 2; ++n4) { bf16x8 bfa[4]; tr_frags4<32, 4 * SD_CLD>(bb + n4 * 128, bfa);
#pragma unroll
                  for (int n1 = 0; n1 < 4; ++n1) { const int nt = n4 * 4 + n1;
                    st[nt][0] = MFMA16(bfa[n1], xw0, st[nt][0]); st[nt][1] = MFMA16(bfa[n1], xw1, st[nt][1]); } }
            }
            bf16* ylane = Yo + (2 * half) * 16 + 4 * fq; asm volatile("" : "+v"(ylane));
#pragma unroll
            for (int tt = 0; tt < 4; ++tt) { const int t = tt * 16 + fr; bf16* yr = ylane + (ptrdiff_t)(dir ? (R0 + 63 - t) : (R0 + t)) * 1024;
#pragma unroll
                for (int pt = 0; pt < 2; ++pt) { v2u w; w.x = pk2(acc[tt][pt][0], acc[tt][pt][1]); w.y = pk2(acc[tt][pt][2], acc[tt][pt][3]); *(v2u*)(yr + pt * 16) = w; } }
        }
        __syncthreads();
    }
#undef SDC_LOAD
}
__device__ __forceinline__ void ssd_chunk_unit(KArgs& a, int l, int unit, LAS unsigned char* lds, int tid) {
    if ((unit >> 2) & 1) { asm volatile("" : "+v"(tid)); ssd_chunk_unit_d<1>(a, l, unit, lds, tid); } else { asm volatile("" : "+v"(tid)); ssd_chunk_unit_d<0>(a, l, unit, lds, tid); }
}

constexpr int AT_KLD = 272, ATO_V = 17408, ATO_BUF = 34816;
__device__ __forceinline__ void attn_unit(KArgs& a, int l, int bl, int j0, int g, LAS unsigned char* lds, int tid) {
    const int lane = tid & 63, wid = __builtin_amdgcn_readfirstlane(tid >> 6), fr = lane & 15, fq = lane >> 4;
    const int hh = wid >> 1, qh = wid & 1, head = g * 4 + hh;
    const bool is_main = j0 >= CTXL; const int t0 = j0 - CTXL;
    const bf16* Ub = (const bf16*)(a.ws + WS_U) + (size_t)bl * RB * NU;
    int i_lo = 0, ntl = 0;
    if (is_main) { i_lo = (t0 < 128) ? (128 - t0) / 64 : 0; const int i_hi = (2176 - t0) / 64 < 5 ? (2176 - t0) / 64 : 5; ntl = i_hi - i_lo; }
    const int ntiles = ntl + 4;
    bf16x8 qf[2][4];
    const bf16* QKb = (const bf16*)(a.ws + WS_QK) + (size_t)bl * RB * 1280;
    { v4u qraw[2][4];
#pragma unroll
      for (int qt = 0; qt < 2; ++qt) { const int jr = j0 + qh * 32 + qt * 16 + fr; const bf16* qr = is_main ? QKb + (size_t)jr * 1280 + head * 128 : Ub + (size_t)jr * NU + UQ + head * 128;
#pragma unroll
          for (int ks = 0; ks < 4; ++ks) qraw[qt][ks] = *(const v4u*)(qr + ks * 32 + 8 * fq); }
      asm volatile("" : "+v"(qraw[0][0]), "+v"(qraw[0][1]), "+v"(qraw[0][2]), "+v"(qraw[0][3]), "+v"(qraw[1][0]), "+v"(qraw[1][1]), "+v"(qraw[1][2]), "+v"(qraw[1][3]));
#pragma unroll
      for (int qt = 0; qt < 2; ++qt)
#pragma unroll
          for (int ks = 0; ks < 4; ++ks) { float q[8]; unpack8(qraw[qt][ks], q);
              v4u w; w.x = pk2(q[0] * 0.12751743f, q[1] * 0.12751743f); w.y = pk2(q[2] * 0.12751743f, q[3] * 0.12751743f);
              w.z = pk2(q[4] * 0.12751743f, q[5] * 0.12751743f); w.w = pk2(q[6] * 0.12751743f, q[7] * 0.12751743f);
              qf[qt][ks] = __builtin_bit_cast(bf16x8, w); } }
    const float sink = a.in[10][l * 8 + head] * 1.44269504f;
    float m[2] = {sink, sink}, ls[2] = {(fq == 0) ? 1.0f : 0.0f, (fq == 0) ? 1.0f : 0.0f};
    f32x4 O[2][8];
#pragma unroll
    for (int qt = 0; qt < 2; ++qt)
#pragma unroll
        for (int dt = 0; dt < 8; ++dt) O[qt][dt] = (f32x4){0.f, 0.f, 0.f, 0.f};
    v4u pk[2], pv[2];
#define AT_LOAD(it_) do { const int it2 = (it_); const int krow0 = (it2 < ntl) ? (CTXL + t0 - 128 + 64 * (i_lo + it2)) : 64 * (it2 - ntl); \
        _Pragma("unroll") for (int i = 0; i < 2; ++i) { const int id = tid + 512 * i; const bf16* kr = Ub + (size_t)(krow0 + (id >> 4)) * NU + g * 128 + (id & 15) * 8; \
            pk[i] = (it2 < ntl) ? *(const v4u*)(QKb + (size_t)(krow0 + (id >> 4)) * 1280 + 1024 + g * 128 + (id & 15) * 8) : *(const v4u*)(kr + UK); pv[i] = *(const v4u*)(kr + UV); } } while (0)
    AT_LOAD(0);
    const int tid_outer = tid;
    for (int it = 0; it < ntiles; ++it) {
        int tid = tid_outer; asm volatile("" : "+v"(tid));
        const int lane = tid & 63, fr = lane & 15, fq = lane >> 4;
        LAS unsigned char* kb = lds + (it & 1) * ATO_BUF; LAS unsigned char* vb = kb + ATO_V;
        const bool local = it < ntl; const int k0 = t0 - 128 + 64 * (i_lo + it);
#pragma unroll
        for (int i = 0; i < 2; ++i) { const int id = tid + 512 * i, key = id >> 4, c16 = id & 15;
            const v4u kw = pk[i];
            *(LAS v4u*)(kb + key * AT_KLD + c16 * 16) = kw;
            *(LAS v4u*)(vb + key * AT_KLD + c16 * 16) = pv[i]; }
        if (it + 1 < ntiles) AT_LOAD(it + 1);
        __syncthreads();
        f32x4 S[2][4];
#pragma unroll
        for (int qt = 0; qt < 2; ++qt)
#pragma unroll
            for (int kt = 0; kt < 4; ++kt) S[qt][kt] = (f32x4){0.f, 0.f, 0.f, 0.f};
#pragma unroll
        for (int ks = 0; ks < 4; ++ks)
#pragma unroll
            for (int kt = 0; kt < 4; ++kt) { const bf16x8 kf = ldfrag(kb, kt * 16 + fr, AT_KLD, ks * 64 + fq * 16); S[0][kt] = MFMA16(kf, qf[0][ks], S[0][kt]); S[1][kt] = MFMA16(kf, qf[1][ks], S[1][kt]); }
        __builtin_amdgcn_sched_barrier(0);
        bf16x8 pf[2][2];
#pragma unroll
        for (int qt = 0; qt < 2; ++qt) {
            if (local) { const int pq = t0 + qh * 32 + qt * 16 + fr;
#pragma unroll
                for (int kt = 0; kt < 4; ++kt)
#pragma unroll
                    for (int r = 0; r < 4; ++r) { const int dlt = pq - (k0 + kt * 16 + 4 * fq + r); if (dlt > 128 || dlt < -128) S[qt][kt][r] = -INFINITY; } }
            float mx = fmaxf(fmaxf(fmaxf(S[qt][0][0], S[qt][0][1]), fmaxf(S[qt][0][2], S[qt][0][3])), fmaxf(fmaxf(S[qt][1][0], S[qt][1][1]), fmaxf(S[qt][1][2], S[qt][1][3])));
            mx = fmaxf(mx, fmaxf(fmaxf(fmaxf(S[qt][2][0], S[qt][2][1]), fmaxf(S[qt][2][2], S[qt][2][3])), fmaxf(fmaxf(S[qt][3][0], S[qt][3][1]), fmaxf(S[qt][3][2], S[qt][3][3]))));
            mx = fmaxf(mx, shx(mx, 16)); mx = fmaxf(mx, shx(mx, 32));
            const float mn = fmaxf(m[qt], mx), alpha = __builtin_amdgcn_exp2f(m[qt] - mn); m[qt] = mn;
            float psum = 0.f;
#pragma unroll
            for (int kt = 0; kt < 4; ++kt)
#pragma unroll
                for (int r = 0; r < 4; ++r) { const float p = __builtin_amdgcn_exp2f(S[qt][kt][r] - mn); S[qt][kt][r] = p; psum += p; }
            ls[qt] = ls[qt] * alpha + psum;
#pragma unroll
            for (int dt = 0; dt < 8; ++dt) O[qt][dt] *= alpha;
#pragma unroll
            for (int k2 = 0; k2 < 2; ++k2) { v4u pw; pw.x = pk2(S[qt][2 * k2][0], S[qt][2 * k2][1]); pw.y = pk2(S[qt][2 * k2][2], S[qt][2 * k2][3]); pw.z = pk2(S[qt][2 * k2 + 1][0], S[qt][2 * k2 + 1][1]); pw.w = pk2(S[qt][2 * k2 + 1][2], S[qt][2 * k2 + 1][3]);
                pf[qt][k2] = __builtin_bit_cast(bf16x8, pw); }
        }
#pragma unroll
        for (int k2 = 0; k2 < 2; ++k2) {
            const unsigned va = lds_addr(vb) + (k2 * 32 + 4 * fq) * AT_KLD + tr_lane(lane, AT_KLD);
#pragma unroll
            for (int d4 = 0; d4 < 2; ++d4) { bf16x8 vfa[4]; tr_frags4<32, 16 * AT_KLD>(va + d4 * 128, vfa);
#pragma unroll
                for (int d1 = 0; d1 < 4; ++d1) { O[0][d4 * 4 + d1] = MFMA16(vfa[d1], pf[0][k2], O[0][d4 * 4 + d1]); O[1][d4 * 4 + d1] = MFMA16(vfa[d1], pf[1][k2], O[1][d4 * 4 + d1]); } }
            __builtin_amdgcn_sched_barrier(0);
        }
    }
#undef AT_LOAD
#pragma unroll
    for (int qt = 0; qt < 2; ++qt) {
        float lt = ls[qt]; lt += shx(lt, 16); lt += shx(lt, 32); const float inv = 1.0f / lt;
        const int jr = j0 + qh * 32 + qt * 16 + fr; const bf16* zr = Ub + (size_t)jr * NU + UAZ + head * 128; bf16* orow = (bf16*)(a.ws + WS_OBR) + (size_t)(bl * RB + jr) * LDK3 + head * 128;
        v2u zws[8];
#pragma unroll
        for (int dt = 0; dt < 8; ++dt) zws[dt] = *(const v2u*)(zr + dt * 16 + 4 * fq);
        asm volatile("" : "+v"(zws[0]), "+v"(zws[1]), "+v"(zws[2]), "+v"(zws[3]), "+v"(zws[4]), "+v"(zws[5]), "+v"(zws[6]), "+v"(zws[7]));
#pragma unroll
        for (int dt = 0; dt < 8; ++dt) { const v2u zw = zws[dt]; const f32x4 o = O[qt][dt] * inv;
            const float z0 = bflo(zw.x), z1 = bfhi(zw.x), z2 = bflo(zw.y), z3 = bfhi(zw.y);
            v2u w; w.x = pk2(o[0] * z0 * fsig(z0), o[1] * z1 * fsig(z1)); w.y = pk2(o[2] * z2 * fsig(z2), o[3] * z3 * fsig(z3));
            *(v2u*)(orow + dt * 16 + 4 * fq) = w; }
    }
}
__device__ __forceinline__ int phase_D_mixers(KArgs& a, int l, unsigned* ctr, LAS unsigned char* lds, int tid) {
    const int n_att = NBP * 64 + ((l == 0) ? NBP * 8 : 0);
    const int n_mix = 160 + n_att;
    volatile LAS int* MISC = (volatile LAS int*)(lds + MISC_OFF);
    for (;;) {
        __syncthreads();
        if (tid == 0) MISC[20] = (int)__hip_atomic_fetch_add(ctr, 1u, __ATOMIC_RELAXED, __HIP_MEMORY_SCOPE_AGENT);
        __syncthreads();
        const int u = MISC[20];
        if (u >= n_mix) break;
        asm volatile("" : "+v"(tid));
        if (u < 128) { for (int rp = 0; rp < ((MK_DUP == 10) ? 2 : 1); ++rp) { mlstm_chunk_unit(a, l, u, lds, tid); if (MK_DUP == 10) __syncthreads(); } }
        else if (u < 160) { for (int rp = 0; rp < ((MK_DUP == 11) ? 2 : 1); ++rp) { ssd_chunk_unit(a, l, u - 128, lds, tid); if (MK_DUP == 11) __syncthreads(); } }
        else { for (int rp = 0; rp < ((MK_DUP == 12) ? 2 : 1); ++rp) {
            const int au = u - 160;
            if (au < NBP * 64) attn_unit(a, l, au >> 6, CTXL + ((au >> 1) & 31) * 64, au & 1, lds, tid);
            else { const int cu = au - NBP * 64; attn_unit(a, l, cu >> 3, ((cu >> 1) & 3) * 64, cu & 1, lds, tid); }
            if (MK_DUP == 12) __syncthreads(); }
        }
    }
    return n_mix;
}
struct ERow { v4u hf[2], hb[2], o[2], z[2], xc[2], sz[2], yf[2], yb[2]; };
__device__ __forceinline__ void e_load(KArgs& a, int rl, int lane, ERow& r) {
    const bf16* ur = (const bf16*)(a.ws + WS_U) + (size_t)rl * NU; const bf16* S = (const bf16*)(a.ws + WS_SC) + (size_t)rl * 1024;
#pragma unroll
    for (int q = 0; q < 2; ++q) { const int col = q * 512 + lane * 8;
        r.hf[q] = *(const v4u*)(S + col); r.hb[q] = *(const v4u*)(S + (size_t)RP * 1024 + col); r.yf[q] = *(const v4u*)(S + (size_t)2 * RP * 1024 + col); r.yb[q] = *(const v4u*)(S + (size_t)3 * RP * 1024 + col);
        r.o[q] = *(const v4u*)(ur + UMO + col); r.z[q] = *(const v4u*)(ur + UMZ + col); r.sz[q] = *(const v4u*)(ur + USZ + col);
        r.xc[q] = *(const v4u*)((const bf16*)(a.ws + WS_XC) + (size_t)rl * 1536 + col); }
}
__device__ __forceinline__ float half_sum(float v) {
    const int l4 = lane4_l();
#pragma unroll
    for (int o = 1; o < 32; o <<= 1) v += bperm_f(l4 ^ (o << 2), v);
    return v;
}
__device__ __forceinline__ void e_finish(KArgs& a, int l, int rl, int lane, const ERow& r) {
    bf16* orow = (bf16*)(a.ws + WS_OBR) + (size_t)rl * LDK3;
#pragma unroll
    for (int q = 0; q < 2; ++q) { const int col = q * 512 + lane * 8;
        float hf[8], hb[8], ov[8], zv[8], v[8]; unpack8(r.hf[q], hf); unpack8(r.hb[q], hb); unpack8(r.o[q], ov); unpack8(r.z[q], zv);
        float ss = 0.f;
#pragma unroll
        for (int k = 0; k < 8; ++k) { v[k] = fsig(ov[k]) * (hf[k] + hb[k]); ss += v[k] * v[k]; }
        ss = half_sum(ss); const float rn = 1.0f / sqrtf(ss * (1.0f / 256.0f) + EPS);
        const f32x4 g0 = *(const f32x4*)(a.in[12] + l * 1024 + col), g1 = *(const f32x4*)(a.in[12] + l * 1024 + col + 4);
        const float gg[8] = {g0.x, g0.y, g0.z, g0.w, g1.x, g1.y, g1.z, g1.w};
#pragma unroll
        for (int k = 0; k < 8; ++k) v[k] = v[k] * rn * gg[k] * zv[k] * fsig(zv[k]);
        v4u w; w.x = pk2(v[0], v[1]); w.y = pk2(v[2], v[3]); w.z = pk2(v[4], v[5]); w.w = pk2(v[6], v[7]);
        *(v4u*)(orow + 1024 + col) = w; }
    float yv[2][8]; float ssq = 0.f;
#pragma unroll
    for (int q = 0; q < 2; ++q) { const int col = q * 512 + lane * 8;
        float yf[8], yb[8], xs[8], zv[8]; unpack8(r.yf[q], yf); unpack8(r.yb[q], yb); unpack8(r.xc[q], xs); unpack8(r.sz[q], zv);
        const float dsk = a.in[17][l * 16 + (col >> 6)];
#pragma unroll
        for (int k = 0; k < 8; ++k) { const float t = (yf[k] + yb[k] + dsk * xs[k]) * zv[k] * fsig(zv[k]); yv[q][k] = t; ssq += t * t; } }
    ssq = wave_sum(ssq); const float rn = 1.0f / sqrtf(ssq * (1.0f / 1024.0f) + EPS);
#pragma unroll
    for (int q = 0; q < 2; ++q) { const int col = q * 512 + lane * 8;
        const f32x4 g0 = *(const f32x4*)(a.in[18] + l * 1024 + col), g1 = *(const f32x4*)(a.in[18] + l * 1024 + col + 4);
        v4u w; w.x = pk2(yv[q][0] * rn * g0.x, yv[q][1] * rn * g0.y); w.y = pk2(yv[q][2] * rn * g0.z, yv[q][3] * rn * g0.w);
        w.z = pk2(yv[q][4] * rn * g1.x, yv[q][5] * rn * g1.y); w.w = pk2(yv[q][6] * rn * g1.z, yv[q][7] * rn * g1.w);
        *(v4u*)(orow + 2048 + col) = w; }
}
__device__ __forceinline__ void phase_E(KArgs& a, int l, int lane, int gw, int NGW) {
    const int nrows = (l == 0) ? RP : NBP * SEQ;
#define E_ROW(i_) ((l == 0) ? (i_) : (((i_) / SEQ) * RB + CTXL + ((i_) % SEQ)))
    for (int i = gw; i < nrows; i += 2 * NGW) {
        const int r0 = E_ROW(i), i1 = i + NGW; const bool two = i1 < nrows; const int r1 = two ? E_ROW(i1) : r0;
        ERow A, B;
        e_load(a, r0, lane, A); if (two) e_load(a, r1, lane, B);
        e_finish(a, l, r0, lane, A);
        if (two) e_finish(a, l, r1, lane, B);
    }
#undef E_ROW
}
__device__ __forceinline__ void phase_C2(KArgs& a, int l, LAS unsigned char* lds, int tid, int G, int c) {
    constexpr int N_ML = NBP * 8, N_SD = NBP * 2 * 36 * 16 / 8, N_CV = RP / 32, N_RP = NBP * 64, N_SR = NBP * 4 * 36;
    for (int u = c; u < N_ML + N_SD + N_CV + N_RP + N_SR; u += G) {
        asm volatile("" : "+v"(tid));
        if (u < N_ML) mlsc_unit(a, l, u, lds, tid);
        else if (u < N_ML + N_SD) sdsc_task(a, l, (u - N_ML) * 8 + __builtin_amdgcn_readfirstlane(tid >> 6), tid & 63);
        else if (u < N_ML + N_SD + N_CV) conv_unit(a, l, u - N_ML - N_SD, tid);
        else if (u < N_ML + N_SD + N_CV + N_RP) rope_unit(a, u - N_ML - N_SD - N_CV, tid);
        else score_unit(a, u - N_ML - N_SD - N_CV - N_RP, lds, tid);
    }
}

constexpr int N_GATE_STATIC = 5 * 256 - NMT * 29;
constexpr int N_PHASES = 2 + NPASS * 14 - (NPASS - 1);
__global__ void __launch_bounds__(512, 2) mk_fwd(Args a_unused) {
    extern __shared__ __attribute__((aligned(16))) unsigned char lds_raw[];
    LAS unsigned char* lds = (LAS unsigned char*)lds_raw;
    KArgs* const kp = (KArgs*)__builtin_amdgcn_kernarg_segment_ptr();
#define FRESH(name) KArgs* name = kp; asm volatile("" : "+s"(name)); int tid = threadIdx.x; asm volatile("" : "+v"(tid)); (void)tid
#define LANE (tid & 63)
#define WAVE (__builtin_amdgcn_readfirstlane(tid >> 6))
#define GG ((int)gridDim.x)
#define CC ((int)blockIdx.x)
    for (int u = threadIdx.x; u < (LDS_BYTES - MISC_OFF) / 4; u += 512) ((LAS unsigned*)(lds + MISC_OFF))[u] = 0u;
    __syncthreads();
    int ph_lo, ph_hi;
    { FRESH(a); ph_lo = a->ph_lo; ph_hi = a->ph_hi;
      if (ph_hi - ph_lo > 1) (void)xcd_barrier_post((unsigned*)(a->ws + WS_CTL) + CW_BAR, (volatile LAS unsigned*)(lds + MISC_OFF) + 8); }
    int ph = 0;
#define IN_PH() (ph_lo <= ph && ph < ph_hi)
#define REPS(k) ((MK_DUP == (k)) ? 2 : 1)
#define SEAM() do { if (ph + 1 < ph_hi || MK_DUP >= 0) { KArgs* ab = kp; asm volatile("" : "+s"(ab)); XcdBarrier bar; bar.bar = (unsigned*)(ab->ws + WS_CTL) + CW_BAR; bar.x = xb_xcc_id(); bar.st = (volatile LAS unsigned*)(lds + MISC_OFF) + 8; xcd_barrier(bar); } } while (0)
    if (IN_PH()) for (int rep = 0; rep < REPS(8); ++rep) { FRESH(a); phase_p0(*a, lds, tid, LANE, WAVE, GG, CC); SEAM(); }
    ++ph;
    for (int pass = 0; pass < NPASS; ++pass) {
        if (pass == 0) { if (IN_PH()) { FRESH(a); phase_B(*a, 0, lds, LANE, CC * 8 + WAVE, GG * 8); p0_gate_weights(*a, 0, lds, LANE, WAVE, CC * 8 + WAVE, GG * 8); SEAM(); } ++ph; }
        for (int l = 0; l < 2; ++l) {
            if (IN_PH()) for (int rep = 0; rep < REPS(0); ++rep) {
                FRESH(a);
                pg8::Gemm g{(const bf16*)(a->ws + ws_hb(pass)), (const bf16*)(a->ws + WS_W1T) + (size_t)l * N1 * LDK, RP, N1, 2048, LDK};
                pg8::TileOrder S{NMT, 29, 0, (l == 0) ? 1 : 2, (l == 0) ? NMT : NBP * 8, 12, (l == 0) ? 0 : 1, -1, N_GATE_STATIC, GG, CC};
                pg8::EpiC E{(bf16*)(a->ws + WS_U), (float*)(a->ws + WS_US), a->in[9] + l * 6144, nullptr, 0.f};
                pg8::gemm_phase<pg8::EpiC, pg8::TileOrder, true, true>(lds, g, S, E);
                SEAM();
            }
            ++ph;
            if (IN_PH()) for (int rep = 0; rep < REPS(1); ++rep) { FRESH(a); phase_C2(*a, l, lds, tid, GG, CC); SEAM(); }
            ++ph;
            if (IN_PH()) {
                FRESH(a);
                unsigned* ctr = (unsigned*)(a->ws + WS_CTL) + CW_QUEUE + 64 * (pass * 2 + l);
                (void)phase_D_mixers(*a, l, ctr, lds, tid);
                volatile LAS int* MISC = (volatile LAS int*)(lds + MISC_OFF);
                { pg8::EpiC E{(bf16*)(a->ws + WS_U), (float*)(a->ws + WS_US), a->in[9] + l * 6144, nullptr, 0.f};
                  pg8::Gemm g{(const bf16*)(a->ws + ws_hb(pass)), (const bf16*)(a->ws + WS_W1T) + (size_t)l * N1 * LDK, RP, N1, 2048, LDK};
                  pg8::QueueOrder S{(unsigned*)(a->ws + WS_CTL) + CW_QUEUE8 + 64 * 8 * (pass * 2 + l), (int)(xb_xcc_id() & 7u), (l == 0) ? NMT : NBP * 8, (l == 0) ? 0 : 1, N_GATE_STATIC + ((l == 0) ? 0 : 48), 0, 0, 0, 0, MISC + 16};
                  __syncthreads();
                  if (tid == 0) { MISC[20] = S.draw(); MISC[17] = S.draw(); }
                  __syncthreads();
                  S.first = MISC[20];
                  pg8::gemm_phase<pg8::EpiC, pg8::QueueOrder, true, true>(lds, g, S, E); }
                { FRESH(a6);
                  const float wmax = __builtin_bit_cast(float, __hip_atomic_load((unsigned*)(a6->ws + WS_CTL) + CW_WMAX + l, __ATOMIC_RELAXED, __HIP_MEMORY_SCOPE_AGENT));
                  pg8::EpiC E{(bf16*)(a6->ws + WS_U), (float*)(a6->ws + WS_US), a6->in[9] + l * 6144, (const float*)(a6->ws + ws_sa8(pass)), wmax * (1.0f / 127.0f)};
                  pg8::Gemm g8{(const bf16*)(a6->ws + ws_hb8(pass)), (const bf16*)(a6->ws + WS_WG8 + (size_t)l * 6144 * LD8) - (size_t)40 * 256 * (LD8 / 2), RP, N1, 1024, LD8 / 2};
                  pg8::QueueOrder S{(unsigned*)(a6->ws + WS_CTL) + CW_QUEUE8 + 64 * 8 * (8 + pass * 2 + l), (int)(xb_xcc_id() & 7u), 0, 0, 0, (l == 0) ? NMT : NBP * 8, (l == 0) ? 0 : 1, 0, 0, MISC + 16};
                  __syncthreads();
                  if (tid == 0) { MISC[20] = S.draw(); MISC[17] = S.draw(); }
                  __syncthreads();
                  S.first = MISC[20];
                  pg8::gemm_phase<pg8::EpiC, pg8::QueueOrder, true, true, true>(lds, g8, S, E); }
                SEAM();
            }
            ++ph;
            if (IN_PH()) for (int rep = 0; rep < REPS(3); ++rep) { FRESH(a); phase_E(*a, l, LANE, CC * 8 + WAVE, GG * 8); SEAM(); }
            ++ph;
            if (IN_PH()) for (int rep = 0; rep < ((l == 0) ? REPS(4) * REPS(40) : REPS(4) * REPS(41) * REPS(42)); ++rep) {
                FRESH(a);
                pg8::Gemm g{(const bf16*)(a->ws + WS_OBR), (const bf16*)(a->ws + WS_WBT) + (size_t)l * 2048 * LDK3, RP, 2048, 3072, LDK3};
                pg8::TileOrder S{(l == 0) ? NMT : NBP * 8, 8, (l == 0) ? 0 : 1, 0, 0, 0, 0, 0, 0, GG, CC};
                pg8::EpiF E{(const bf16*)(a->ws + WS_U), (bf16*)(a->ws + WS_MG), (MK_DUP == 42 && l == 1 && rep == 0) ? 1 : 0};
                pg8::gemm_phase<pg8::EpiF, pg8::TileOrder, true, true>(lds, g, S, E);
                if (l == 0) { const int skip = (GG > 64) ? 32 : 0; if (CC >= skip) { FRESH(a2); if (pass == 0) { p0_weights(*a2, 1, lds, LANE, WAVE, (CC - skip) * 8 + WAVE, (GG - skip) * 8); p0_gate_weights(*a2, 1, lds, LANE, WAVE, (CC - skip) * 8 + WAVE, (GG - skip) * 8); }
                    if (pass > 0) phase_H(*a2, pass - 1, 1, lds, LANE, (CC - skip) * 8 + WAVE, (GG - skip) * 8); } }
                SEAM();
            }
            ++ph;
            if (IN_PH()) for (int rep = 0; rep < ((l == 0) ? REPS(5) * REPS(50) : REPS(5) * REPS(51)); ++rep) {
                FRESH(a);
                pg8::Gemm g{(const bf16*)(a->ws + WS_MG), (const bf16*)(a->ws + WS_WOT) + (size_t)l * 2048 * LDK, RP, 2048, 2048, LDK};
                pg8::TileOrder S{(l == 0) ? NMT : NBP * 8, 8, (l == 0) ? 0 : 1, 0, 0, 0, 0, 0, 0, GG, CC};
                pg8::EpiG E{(bf16*)(a->ws + WS_Y), 2048};
                pg8::gemm_phase<pg8::EpiG, pg8::TileOrder, true, true>(lds, g, S, E);
                if (l == 0 && pass + 1 < NPASS) { const int skip = (GG > 64) ? 32 : 0; if (CC >= skip) { FRESH(a2); phase_B(*a2, pass + 1, lds, LANE, (CC - skip) * 8 + WAVE, (GG - skip) * 8); } }
                SEAM();
            }
            ++ph;
            if (l == 0 || pass == NPASS - 1) { if (IN_PH()) for (int rep = 0; rep < ((l == 0) ? REPS(6) : 1); ++rep) { FRESH(a); phase_H(*a, pass, l, lds, LANE, CC * 8 + WAVE, GG * 8); SEAM(); } ++ph; }
        }
    }
#undef IN_PH
#undef SEAM
}

extern "C" void kernel_launch(void* const* d_in, const int* in_sizes, int n_in, void* d_out, int out_size, void* d_ws, size_t ws_size, hipStream_t stream) {
    static int grid = 0;
    if (grid == 0) {
        if (n_in != 22 || out_size != NBATCH * SEQ * DM || ws_size < WS_END) { fprintf(stderr, "kernel_launch: unexpected problem: n_in %d out %d ws %zu (need %zu)\n", n_in, out_size, ws_size, (size_t)WS_END); grid = -1; return; }
        int dev = 0, cus = 0, per_cu = 0;
        if (hipGetDevice(&dev) != hipSuccess || hipDeviceGetAttribute(&cus, hipDeviceAttributeMultiprocessorCount, dev) != hipSuccess) { grid = -1; return; }
        if (hipFuncSetAttribute((const void*)mk_fwd, hipFuncAttributeMaxDynamicSharedMemorySize, LDS_BYTES) != hipSuccess) { fprintf(stderr, "kernel_launch: hipFuncSetAttribute failed\n"); grid = -1; return; }
        if (hipOccupancyMaxActiveBlocksPerMultiprocessor(&per_cu, (const void*)mk_fwd, 512, LDS_BYTES) != hipSuccess || per_cu < 1) fprintf(stderr, "kernel_launch: occupancy query reports %d\n", per_cu);
        (void)hipGetLastError();
        grid = cus;
    }
    if (grid < 0) return;
    if (hipMemsetAsync((char*)d_ws + WS_CTL, 0, CTL_ZERO_BYTES, stream) != hipSuccess) return;
    Args a{};
    for (int i = 0; i < 22; ++i) a.in[i] = (const float*)d_in[i];
    a.out = (float*)d_out; a.ws = (unsigned char*)d_ws;
#if MK_N_LAUNCHES == 1
    a.ph_lo = 0; a.ph_hi = N_PHASES;
    hipLaunchKernelGGL(mk_fwd, dim3(grid), dim3(512), LDS_BYTES, stream, a);
#else
    for (int ph = 0; ph < N_PHASES; ++ph) { a.ph_lo = ph; a.ph_hi = ph + 1; hipLaunchKernelGGL(mk_fwd, dim3(grid), dim3(512), LDS_BYTES, stream, a); }
#endif
}
```
